# Optimizing an MI355X kernel written in HIP

```python
import math
import jax, jax.numpy as jnp
from jax import lax
import numpy as np

D_MODEL = 1024
BATCH = 8
SEQ = 2048
DEPTH = 4

N_MIXERS = 2
N_MOBA_LAYERS = (DEPTH + 1) // 2
N_DIFF_LAYERS = DEPTH // 2
MOBA_HEAD_DIM = 64
MOBA_HEADS = D_MODEL // MOBA_HEAD_DIM
MOBA_BLOCK = 256
MOBA_TOPK = 3
MOBA_Q_CHUNK = 16
DIFF_HEAD_DIM = 64
DIFF_HEADS = D_MODEL // (2 * DIFF_HEAD_DIM)
DIFF_Q_BLOCK = 128
D_FF = 4 * D_MODEL
ROPE_THETA = 500000.0
MOBA_ROT = MOBA_HEAD_DIM // 4
DIFF_ROT = DIFF_HEAD_DIM // 4
DEEPNORM_ALPHA = (2.0 * DEPTH) ** 0.25
DEEPNORM_BETA = (8.0 * DEPTH) ** -0.25
LN_EPS = 1e-5
SUBLN_EPS = 1e-5
ADA_SCALE = 0.1
NEG_INF = -1e30

kernel_name = "moba_diffattn_deepnorm_adaln_hybrid"


def rope_tables(seq_len, rot_dim):
    pos = jnp.arange(seq_len, dtype=jnp.float32)
    inv = ROPE_THETA ** (-jnp.arange(0, rot_dim, 2, dtype=jnp.float32) / rot_dim)
    ang = pos[:, None] * inv[None, :]
    return jnp.cos(ang), jnp.sin(ang)


def partial_rope(x, cos, sin):
    half = cos.shape[-1]
    x1, x2, xp = x[..., :half], x[..., half:2 * half], x[..., 2 * half:]
    c = cos.astype(x.dtype)
    s = sin.astype(x.dtype)
    return jnp.concatenate([x1 * c - x2 * s, x2 * c + x1 * s, xp], axis=-1)


def layer_norm(x, g, b):
    xf = x.astype(jnp.float32)
    mu = jnp.mean(xf, axis=-1, keepdims=True)
    var = jnp.mean(jnp.square(xf - mu), axis=-1, keepdims=True)
    return ((xf - mu) * lax.rsqrt(var + LN_EPS)).astype(x.dtype) * g + b


def rms_norm(x, g):
    xf = x.astype(jnp.float32)
    return (xf * lax.rsqrt(jnp.mean(jnp.square(xf), axis=-1, keepdims=True) + SUBLN_EPS)).astype(x.dtype) * g


def moba_attention(h, w_in, w_out):
    B, S, _ = h.shape
    H, hd, BLK, QC = MOBA_HEADS, MOBA_HEAD_DIM, MOBA_BLOCK, MOBA_Q_CHUNK
    cos, sin = rope_tables(S, MOBA_ROT)
    q, k, v = jnp.split(h @ w_in, 3, axis=-1)
    to_heads = lambda t: t.reshape(B, S, H, hd).transpose(0, 2, 1, 3)
    q = partial_rope(to_heads(q), cos, sin)
    k = partial_rope(to_heads(k), cos, sin)
    v = to_heads(v)
    nb = -(-S // BLK)
    pad = nb * BLK - S
    k_blocks = jnp.pad(k, ((0, 0), (0, 0), (0, pad), (0, 0))).reshape(B, H, nb, BLK, hd)
    v_blocks = jnp.pad(v, ((0, 0), (0, 0), (0, pad), (0, 0))).reshape(B, H, nb, BLK, hd)
    scale = hd ** -0.5
    q_block = jnp.arange(S) // BLK
    n_sel = min(MOBA_TOPK, nb - 1)
    nc = S // QC

    def chunk(t):
        return jnp.moveaxis(t.reshape(t.shape[:2] + (nc, QC) + t.shape[3:]), 2, 0)

    xs = {"q": chunk(q), "start": jnp.arange(nc, dtype=jnp.int32) * QC}
    if n_sel > 0:
        k_mean = jnp.mean(k_blocks.astype(jnp.float32), axis=3)
        gate = jnp.einsum('bhsd,bhnd->bhsn', q.astype(jnp.float32), k_mean)
        past = jnp.arange(nb)[None, :] < q_block[:, None]
        gate = jnp.where(past, gate, NEG_INF)
        _, sel_idx = lax.top_k(gate, n_sel)
        sel_valid = jnp.arange(n_sel)[None, :] < q_block[:, None]
        xs["idx"] = chunk(sel_idx)
        xs["valid"] = sel_valid.reshape(nc, QC, n_sel)
    b_ix = jnp.arange(B)[:, None, None, None]
    h_ix = jnp.arange(H)[None, :, None, None]

    def step(a):
        q_c, start = a["q"], a["start"]
        own = start // BLK
        k_own = lax.dynamic_index_in_dim(k_blocks, own, axis=2, keepdims=False)
        v_own = lax.dynamic_index_in_dim(v_blocks, own, axis=2, keepdims=False)
        q_pos = start + jnp.arange(QC)
        k_pos = own * BLK + jnp.arange(BLK)
        s_own = jnp.einsum('bhqd,bhkd->bhqk', q_c, k_own).astype(jnp.float32) * scale
        s_own = jnp.where(k_pos[None, :] <= q_pos[:, None], s_own, NEG_INF)
        if n_sel == 0:
            p = jax.nn.softmax(s_own, axis=-1).astype(v.dtype)
            return jnp.einsum('bhqk,bhkd->bhqd', p, v_own)
        idx_c = a["idx"]
        k_sel = k_blocks[b_ix, h_ix, idx_c]
        v_sel = v_blocks[b_ix, h_ix, idx_c]
        s_sel = jnp.einsum('bhqd,bhqnkd->bhqnk', q_c, k_sel).astype(jnp.float32) * scale
        s_sel = jnp.where(a["valid"][None, None, :, :, None], s_sel, NEG_INF)
        s_all = jnp.concatenate([s_own, s_sel.reshape(B, H, QC, n_sel * BLK)], axis=-1)
        p = jax.nn.softmax(s_all, axis=-1).astype(v.dtype)
        p_own = p[..., :BLK]
        p_sel = p[..., BLK:].reshape(B, H, QC, n_sel, BLK)
        return (jnp.einsum('bhqk,bhkd->bhqd', p_own, v_own)
                + jnp.einsum('bhqnk,bhqnkd->bhqd', p_sel, v_sel))

    o = lax.map(step, xs)
    o = jnp.moveaxis(o, 0, 2).reshape(B, H, S, hd)
    return o.transpose(0, 2, 1, 3).reshape(B, S, H * hd) @ w_out


def diff_attention(h, w_in, w_out, lam_q1, lam_k1, lam_q2, lam_k2, subln_g, lambda_init):
    B, S, _ = h.shape
    H, d, QB = DIFF_HEADS, DIFF_HEAD_DIM, DIFF_Q_BLOCK
    cos, sin = rope_tables(S, DIFF_ROT)
    q, k, v = jnp.split(h @ w_in, 3, axis=-1)
    q = partial_rope(q.reshape(B, S, H, 2, d).transpose(0, 2, 3, 1, 4), cos, sin)
    k = partial_rope(k.reshape(B, S, H, 2, d).transpose(0, 2, 3, 1, 4), cos, sin)
    v = v.reshape(B, S, H, 2 * d).transpose(0, 2, 1, 3)
    f32 = jnp.float32
    lam = (jnp.exp(jnp.sum(lam_q1.astype(f32) * lam_k1.astype(f32)))
           - jnp.exp(jnp.sum(lam_q2.astype(f32) * lam_k2.astype(f32))) + lambda_init)
    nqb = S // QB
    q_blocks = jnp.moveaxis(q.reshape(B, H, 2, nqb, QB, d), 3, 0)
    k_pos = jnp.arange(S)
    scale = d ** -0.5

    def step(a):
        q_b, start = a
        s = jnp.einsum('bhcqd,bhckd->bhcqk', q_b, k).astype(f32) * scale
        q_pos = start + jnp.arange(QB)
        s = jnp.where(k_pos[None, :] <= q_pos[:, None], s, NEG_INF)
        p = jax.nn.softmax(s, axis=-1)
        w = (p[:, :, 0] - lam * p[:, :, 1]).astype(v.dtype)
        return jnp.einsum('bhqk,bhke->bhqe', w, v)

    o = lax.map(step, (q_blocks, jnp.arange(nqb, dtype=jnp.int32) * QB))
    o = jnp.moveaxis(o, 0, 2).reshape(B, H, S, 2 * d)
    o = rms_norm(o, subln_g) * (1.0 - lambda_init)
    return o.transpose(0, 2, 1, 3).reshape(B, S, H * 2 * d) @ w_out


def sq_relu_mlp(h, w_up, w_down):
    return jnp.square(jax.nn.relu(h @ w_up)) @ w_down


def setup_inputs(seed: int = 0) -> dict:
    key = jax.random.key(seed)
    ks = jax.random.split(key, 20)
    D = D_MODEL
    nrm = lambda k, shape: jax.random.normal(k, shape, dtype=jnp.float32)
    in_col_scale = jnp.concatenate([jnp.ones((2 * D,), jnp.float32),
                                    jnp.full((D,), DEEPNORM_BETA, jnp.float32)])
    return {
        "x": nrm(ks[0], (BATCH, SEQ, D)),
        "c": nrm(ks[1], (BATCH, D)),
        "moba_w_in": nrm(ks[2], (N_MOBA_LAYERS, D, 3 * D)) * D ** -0.5 * in_col_scale,
        "moba_w_out": nrm(ks[3], (N_MOBA_LAYERS, D, D)) * D ** -0.5 * DEEPNORM_BETA,
        "diff_w_in": nrm(ks[4], (N_DIFF_LAYERS, D, 3 * D)) * D ** -0.5 * in_col_scale,
        "diff_w_out": nrm(ks[5], (N_DIFF_LAYERS, D, D)) * D ** -0.5 * DEEPNORM_BETA,
        "diff_lam_q1": nrm(ks[6], (N_DIFF_LAYERS, DIFF_HEAD_DIM)) * 0.1,
        "diff_lam_k1": nrm(ks[7], (N_DIFF_LAYERS, DIFF_HEAD_DIM)) * 0.1,
        "diff_lam_q2": nrm(ks[8], (N_DIFF_LAYERS, DIFF_HEAD_DIM)) * 0.1,
        "diff_lam_k2": nrm(ks[9], (N_DIFF_LAYERS, DIFF_HEAD_DIM)) * 0.1,
        "diff_subln_g": 1.0 + 0.02 * nrm(ks[10], (N_DIFF_LAYERS, 2 * DIFF_HEAD_DIM)),
        "ada_w": nrm(ks[11], (DEPTH, D, 6 * D)) * D ** -0.5 * ADA_SCALE,
        "ada_b": 0.02 * nrm(ks[12], (DEPTH, 6 * D)),
        "ln_g": 1.0 + 0.02 * nrm(ks[13], (DEPTH, 2, D)),
        "ln_b": 0.02 * nrm(ks[14], (DEPTH, 2, D)),
        "mlp_w_up": nrm(ks[15], (DEPTH, D, D_FF)) * D ** -0.5,
        "mlp_w_down": nrm(ks[16], (DEPTH, D_FF, D)) * D_FF ** -0.5 * DEEPNORM_BETA,
    }


def reference(x, c, moba_w_in, moba_w_out, diff_w_in, diff_w_out, diff_lam_q1, diff_lam_k1,
              diff_lam_q2, diff_lam_k2, diff_subln_g, ada_w, ada_b, ln_g, ln_b, mlp_w_up, mlp_w_down):
    mod = jnp.einsum('bd,lde->lbe', jax.nn.silu(c), ada_w) + ada_b[:, None, :]
    for i in range(DEPTH):
        shift1, scale1, gate1, shift2, scale2, gate2 = [m[:, None, :] for m in jnp.split(mod[i], 6, axis=-1)]
        j = i // N_MIXERS
        h = x * (1.0 + scale1) + shift1
        if i % N_MIXERS == 0:
            y = moba_attention(h, moba_w_in[j], moba_w_out[j])
        else:
            lambda_init = 0.8 - 0.6 * math.exp(-0.3 * i)
            y = diff_attention(h, diff_w_in[j], diff_w_out[j], diff_lam_q1[j], diff_lam_k1[j],
                               diff_lam_q2[j], diff_lam_k2[j], diff_subln_g[j], lambda_init)
        x = layer_norm(DEEPNORM_ALPHA * x + (1.0 + gate1) * y, ln_g[i, 0], ln_b[i, 0])
        h = x * (1.0 + scale2) + shift2
        y = sq_relu_mlp(h, mlp_w_up[i], mlp_w_down[i])
        x = layer_norm(DEEPNORM_ALPHA * x + (1.0 + gate2) * y, ln_g[i, 1], ln_b[i, 1])
    return x
```

```cpp
#include <hip/hip_runtime.h>
#include <cstdio>
#include <cstdint>
#include <cmath>
namespace pg8 {
#define PG8_LAS __attribute__((address_space(3)))
typedef unsigned short bf16_t;
typedef short bf16x8 __attribute__((ext_vector_type(8)));
typedef float f32x4 __attribute__((ext_vector_type(4)));
typedef unsigned u32x4 __attribute__((ext_vector_type(4)));
constexpr int BM = 256, BK = 64, HALF = 128, HTB = HALF * BK * 2  , STAGE_BYTES = 8 * HTB, NXCD = 8, WGM = 8;

__host__ __device__ __forceinline__ int lds_byte(int r, int c) { const int st = (r >> 4) * 2 + (c >> 5), rr = r & 15, cc = c & 31, ob = rr * 64 + cc * 2; return st * 1024 + (ob ^ (((ob >> 9) & 1) << 5)); }
__host__ __device__ __forceinline__ void stage_rc(int b, int& R, int& C) { const int st = b / 1024, sb = b % 1024, swz = sb ^ (((sb >> 9) & 1) << 5); R = (st >> 1) * 16 + swz / 64; C = (st & 1) * 32 + (swz % 64) / 2; }
__host__ __device__ __forceinline__ int perm32(int rho) { const int n = rho >> 4, i = rho & 15; return 8 * (i >> 2) + 4 * n + (i & 3); }

struct Unit { int pm, pn; };
struct Gemm { const bf16_t* A; const bf16_t* Bt; int M, N, K; };

struct StaticOrder {
    int nM, nN, nwg, G, c;
    __host__ __device__ void init(int M, int N, int G_, int c_) { nM = M / BM; nN = N / BM; nwg = nM * nN; G = G_; c = c_; }
    __host__ __device__ bool next(int i, Unit& u) const {
        const long L = (long)i * G + c; if (L >= nwg) return false;
        int wgid = (int)L; { const int q = nwg / NXCD, r = nwg % NXCD, xcd = wgid % NXCD, off = wgid / NXCD; wgid = (xcd < r ? xcd * (q + 1) : r * (q + 1) + (xcd - r) * q) + off; }
        const int nig = WGM * nN, gid = wgid / nig, fm = gid * WGM, gsz = (nM - fm) < WGM ? (nM - fm) : WGM;
        u.pm = fm + ((wgid % nig) % gsz); u.pn = (wgid % nig) / gsz; return true;
    }
    __device__ __forceinline__ void a_ready(const Unit&) const {}
    __device__ __forceinline__ void done(const Unit&) const {}
};

__device__ __forceinline__ unsigned cvt_pk_bf16(float lo, float hi) { unsigned r; asm volatile("v_cvt_pk_bf16_f32 %0, %1, %2" : "=v"(r) : "v"(lo), "v"(hi)); return r; }
typedef float f32x2 __attribute__((ext_vector_type(2)));
struct EpiQKV {
    static constexpr bool PERM = true, AFTER_DRAIN = false;
    bf16_t* Q; size_t tstride;
    const float* rope;
    float* kpart;
    float qscale;
    __device__ __forceinline__ void operator()(const f32x4 (&acc)[2][2][4][2], const Unit& u, int wr, int wc, int fr, int fq) const {
        asm volatile("" : "+v"(fr), "+v"(fq));
        const int t = u.pn >> 2;
        bf16_t* base = Q + (size_t)t * tstride;
        const int colt = (u.pn & 3) * BM;
        const int col0 = colt + wc * 32 + 8 * fq;
        const float sc = (t == 0) ? qscale : 1.f;
        const bool do_rope = (t < 2) && ((wc & 1) == 0);
        const bool do_ksum = (t == 1) && (kpart != nullptr);
        const float sg = (fq == 0) ? -1.f : 1.f;
        float ks[2][8];
#pragma unroll
        for (int bj = 0; bj < 2; ++bj)
#pragma unroll
            for (int e = 0; e < 8; ++e) ks[bj][e] = 0.f;
#pragma unroll
        for (int ai = 0; ai < 2; ++ai)
#pragma unroll
            for (int m = 0; m < 4; ++m) {
                const int row = u.pm * BM + ai * HALF + wr * 64 + m * 16 + fr;
                const int pos = row & 2047;
                bf16_t* rowp = base + (size_t)row * 1024 + col0;
                f32x4 c0 = {1.f, 1.f, 1.f, 1.f}, c1 = c0, s0 = {0.f, 0.f, 0.f, 0.f}, s1 = s0;
                if (do_rope && fq < 2) { const float* cs = rope + pos * 16; c0 = *(const f32x4*)(cs); c1 = *(const f32x4*)(cs + 4); s0 = *(const f32x4*)(cs + 8); s1 = *(const f32x4*)(cs + 12); }
#pragma unroll
                for (int bj = 0; bj < 2; ++bj) {
                    f32x4 v0 = acc[ai][bj][m][0], v1 = acc[ai][bj][m][1];
                    if (do_rope) {
                        f32x4 p0, p1;
#pragma unroll
                        for (int e = 0; e < 4; ++e) { p0[e] = __shfl_xor(v0[e], 16); p1[e] = __shfl_xor(v1[e], 16); }
                        v0 = v0 * c0 + (p0 * s0) * sg; v1 = v1 * c1 + (p1 * s1) * sg;
                    }
                    if (do_ksum) {
#pragma unroll
                        for (int e = 0; e < 4; ++e) { ks[bj][e] += v0[e]; ks[bj][4 + e] += v1[e]; }
                    }
                    v0 = v0 * sc; v1 = v1 * sc;
                    u32x4 w; w.x = cvt_pk_bf16(v0[0], v0[1]); w.y = cvt_pk_bf16(v0[2], v0[3]); w.z = cvt_pk_bf16(v1[0], v1[1]); w.w = cvt_pk_bf16(v1[2], v1[3]);
                    *(u32x4*)(rowp + bj * HALF) = w;
                }
            }
        if (do_ksum) {
#pragma unroll
            for (int bj = 0; bj < 2; ++bj)
#pragma unroll
                for (int e = 0; e < 8; ++e) { float v = ks[bj][e]; v += __shfl_xor(v, 1); v += __shfl_xor(v, 2); v += __shfl_xor(v, 4); v += __shfl_xor(v, 8); ks[bj][e] = v; }
            if (fr == 0) {
                float* kp = kpart + ((size_t)(u.pm * 2 + wr)) * 1024 + col0;
#pragma unroll
                for (int bj = 0; bj < 2; ++bj) { *(f32x4*)(kp + bj * HALF) = (f32x4){ks[bj][0], ks[bj][1], ks[bj][2], ks[bj][3]}; *(f32x4*)(kp + bj * HALF + 4) = (f32x4){ks[bj][4], ks[bj][5], ks[bj][6], ks[bj][7]}; }
            }
        }
    }
};
struct EpiSqRelu {
    static constexpr bool PERM = true, AFTER_DRAIN = false;
    bf16_t* O; int ldc;
    __device__ __forceinline__ void operator()(const f32x4 (&acc)[2][2][4][2], const Unit& u, int wr, int wc, int fr, int fq) const {
        asm volatile("" : "+v"(fr), "+v"(fq));
        const int row0 = u.pm * BM + wr * 64 + fr; const int col0 = u.pn * BM + wc * 32 + 8 * fq;
#pragma unroll
        for (int ai = 0; ai < 2; ++ai)
#pragma unroll
            for (int m = 0; m < 4; ++m) { bf16_t* rowp = O + (size_t)(row0 + ai * HALF + m * 16) * ldc + col0;
#pragma unroll
                for (int bj = 0; bj < 2; ++bj) { f32x4 v0 = acc[ai][bj][m][0], v1 = acc[ai][bj][m][1];
#pragma unroll
                    for (int e = 0; e < 4; ++e) { const float a = fmaxf(v0[e], 0.f), b = fmaxf(v1[e], 0.f); v0[e] = a * a; v1[e] = b * b; }
                    u32x4 w; w.x = cvt_pk_bf16(v0[0], v0[1]); w.y = cvt_pk_bf16(v0[2], v0[3]); w.z = cvt_pk_bf16(v1[0], v1[1]); w.w = cvt_pk_bf16(v1[2], v1[3]);
                    *(u32x4*)(rowp + bj * HALF) = w; } }
    }
};
struct EpiResid {
    static constexpr bool PERM = false, AFTER_DRAIN = false;
    const float* xin; float* out; const float* gate; float alpha;
    __device__ __forceinline__ void operator()(const f32x4 (&acc)[2][2][4][2], const Unit& u, int wr, int wc, int fr, int fq) const {
        asm volatile("" : "+v"(fr), "+v"(fq));
        const int col0 = u.pn * BM + wc * 32 + 4 * fq; const int b = u.pm >> 3;
        f32x4 g[2][2];
#pragma unroll
        for (int bj = 0; bj < 2; ++bj)
#pragma unroll
            for (int n = 0; n < 2; ++n) g[bj][n] = *(const f32x4*)(gate + b * 6144 + col0 + bj * HALF + n * 16) + 1.0f;
#pragma unroll
        for (int ai = 0; ai < 2; ++ai)
#pragma unroll
            for (int m = 0; m < 4; ++m) { const size_t off = (size_t)(u.pm * BM + ai * HALF + wr * 64 + m * 16 + fr) * 1024 + col0;
#pragma unroll
                for (int bj = 0; bj < 2; ++bj)
#pragma unroll
                    for (int n = 0; n < 2; ++n) { const f32x4 xv = *(const f32x4*)(xin + off + bj * HALF + n * 16);
                        *(f32x4*)(out + off + bj * HALF + n * 16) = xv * alpha + g[bj][n] * acc[ai][bj][m][n]; } }
    }
};

template <class Epi, class Sched, bool ALIGN_EPI = false, bool SP2 = false>
__device__ __forceinline__ void gemm_phase(PG8_LAS unsigned char* lds, const Gemm g, const Sched& S, const Epi& E) {
    int tid_l = threadIdx.x; asm volatile("" : "+v"(tid_l));
    const int tid = tid_l, wid = __builtin_amdgcn_readfirstlane(tid >> 6), lane = tid & 63, wr = wid >> 2, wc = wid & 3, fr = lane & 15, fq = lane >> 4;
    const int K = g.K, nt = K / BK;
    unsigned voffA[2], voffB[2];
#pragma unroll
    for (int i = 0; i < 2; ++i) { int R, C; stage_rc(tid * 16 + i * 8192, R, C); const int Rb = Epi::PERM ? ((R & ~31) + perm32(R & 31)) : R;
        voffA[i] = (unsigned)(R * K + C) * 2u; voffB[i] = (unsigned)(Rb * K + C) * 2u; }
    const size_t kstep = (size_t)(BK * 2);
    const size_t hstep = (size_t)HALF * K * 2;
    const size_t tstep = 2 * hstep;
    const unsigned ldsw = (unsigned)wid * 1024u;
    const int aoff = lds_byte(wr * 64 + fr, fq * 8), boff = lds_byte(wc * 32 + fr, fq * 8);
#define PG8_SA(b, h) (((b) * 2 + (h)) * HTB)
#define PG8_SB(b, h) ((4 + (b) * 2 + (h)) * HTB)
#define PG8_STAGE(bufoff, gbase, voff) do { _Pragma("unroll") for (int _i = 0; _i < 2; ++_i) \
        __builtin_amdgcn_global_load_lds((const unsigned*)((const char*)(gbase) + (voff)[_i]), (PG8_LAS unsigned*)(lds + (bufoff) + ldsw + _i * 8192), 16, 0, 0); } while (0)
#define PG8_LDA(dst, b, h) do { _Pragma("unroll") for (int m = 0; m < 4; ++m) _Pragma("unroll") for (int k = 0; k < 2; ++k) dst[m][k] = *(const PG8_LAS bf16x8*)(lds + PG8_SA(b, h) + aoff + m * 2048 + k * 1024); } while (0)
#define PG8_LDB(dst, b, h) do { _Pragma("unroll") for (int n = 0; n < 2; ++n) _Pragma("unroll") for (int k = 0; k < 2; ++k) dst[n][k] = *(const PG8_LAS bf16x8*)(lds + PG8_SB(b, h) + boff + n * 2048 + k * 1024); } while (0)
#define PG8_MMA(ai, bj, At, Bt) do { __builtin_amdgcn_s_setprio(1); _Pragma("unroll") for (int m = 0; m < 4; ++m) _Pragma("unroll") for (int n = 0; n < 2; ++n) _Pragma("unroll") for (int k = 0; k < 2; ++k) \
        acc[ai][bj][m][n] = __builtin_amdgcn_mfma_f32_16x16x32_bf16(Bt[n][k], At[m][k], acc[ai][bj][m][n], 0, 0, 0); __builtin_amdgcn_s_setprio(0); } while (0)
#define PG8_WAIT_V(n) asm volatile("s_waitcnt vmcnt(" #n ")" ::: "memory")
#define PG8_WAIT_L(n) asm volatile("s_waitcnt lgkmcnt(" #n ")" ::: "memory")
#define PG8_BAR __builtin_amdgcn_s_barrier()
#define PG8_SCHED __builtin_amdgcn_sched_barrier(0)
    Unit cur, nxt; int ui = 0;
    if (!S.next(0, cur)) return;
    f32x4 acc[2][2][4][2];
#pragma unroll
    for (int a = 0; a < 2; ++a)
#pragma unroll
        for (int b = 0; b < 2; ++b)
#pragma unroll
            for (int m = 0; m < 4; ++m)
#pragma unroll
                for (int n = 0; n < 2; ++n) acc[a][b][m][n] = (f32x4){0.f, 0.f, 0.f, 0.f};
    bf16x8 At[4][2], B0[2][2], B1[2][2];
    const char* cA = (const char*)g.A + (size_t)cur.pm * tstep; const char* cB = (const char*)g.Bt + (size_t)cur.pn * tstep;
    S.a_ready(cur);
    if constexpr (SP2) {
        PG8_STAGE(PG8_SB(0, 0), cB, voffB); PG8_STAGE(PG8_SB(0, 1), cB + hstep, voffB); PG8_STAGE(PG8_SA(0, 0), cA, voffA); PG8_STAGE(PG8_SA(0, 1), cA + hstep, voffA);
        if (wr == 1) PG8_BAR;
        PG8_WAIT_V(2); PG8_BAR;
        PG8_STAGE(PG8_SB(1, 0), cB + kstep, voffB); PG8_STAGE(PG8_SA(1, 0), cA + kstep, voffA); PG8_STAGE(PG8_SB(1, 1), cB + hstep + kstep, voffB);
        PG8_WAIT_V(6); PG8_BAR;
    } else {
        PG8_STAGE(PG8_SB(0, 0), cB, voffB); PG8_STAGE(PG8_SA(0, 0), cA, voffA); PG8_STAGE(PG8_SB(0, 1), cB + hstep, voffB); PG8_STAGE(PG8_SA(0, 1), cA + hstep, voffA);
        if (wr == 1) PG8_BAR;
        PG8_WAIT_V(4); PG8_BAR;
        PG8_STAGE(PG8_SB(1, 0), cB + kstep, voffB); PG8_STAGE(PG8_SA(1, 0), cA + kstep, voffA); PG8_STAGE(PG8_SB(1, 1), cB + hstep + kstep, voffB);
        PG8_WAIT_V(6); PG8_BAR;
    }
    for (;;) {
        const bool has_next = S.next(ui + 1, nxt);
        const char* nA = has_next ? (const char*)g.A + (size_t)nxt.pm * tstep : cA; const char* nB = has_next ? (const char*)g.Bt + (size_t)nxt.pn * tstep : cB;
        for (int t = 0; t < nt; t += 2) {
            const bool last = (t == nt - 2);
            const char* a1 = cA + (size_t)(t + 1) * kstep;
            const char* a2 = last ? nA : cA + (size_t)(t + 2) * kstep; const char* b2 = last ? nB : cB + (size_t)(t + 2) * kstep;
            const char* a3 = a2 + kstep; const char* b3 = b2 + kstep;
            if (last && has_next) S.a_ready(nxt);
            if constexpr (SP2) {
            PG8_LDB(B0, 0, 0); PG8_LDB(B1, 0, 1); PG8_SCHED; PG8_LDA(At, 0, 0); PG8_STAGE(PG8_SA(1, 1), a1 + hstep, voffA);
            PG8_WAIT_V(8); PG8_WAIT_L(0); PG8_BAR; PG8_MMA(0, 0, At, B0); PG8_MMA(0, 1, At, B1); PG8_BAR; PG8_SCHED;
            PG8_LDA(At, 0, 1); PG8_STAGE(PG8_SB(0, 0), b2, voffB); PG8_STAGE(PG8_SB(0, 1), b2 + hstep, voffB); PG8_STAGE(PG8_SA(0, 0), a2, voffA);
            PG8_WAIT_V(8); PG8_WAIT_L(0); PG8_BAR; PG8_MMA(1, 0, At, B0); PG8_MMA(1, 1, At, B1); PG8_BAR; PG8_SCHED;
            PG8_LDB(B0, 1, 0); PG8_LDB(B1, 1, 1); PG8_SCHED; PG8_LDA(At, 1, 0); PG8_STAGE(PG8_SA(0, 1), a2 + hstep, voffA);
            PG8_WAIT_V(8); PG8_WAIT_L(0); PG8_BAR; PG8_MMA(0, 0, At, B0); PG8_MMA(0, 1, At, B1); PG8_BAR; PG8_SCHED;
            PG8_LDA(At, 1, 1); PG8_STAGE(PG8_SB(1, 0), b3, voffB); PG8_STAGE(PG8_SB(1, 1), b3 + hstep, voffB); PG8_STAGE(PG8_SA(1, 0), a3, voffA);
            PG8_WAIT_V(8); PG8_WAIT_L(0); PG8_BAR; PG8_MMA(1, 0, At, B0); PG8_MMA(1, 1, At, B1); PG8_BAR; PG8_SCHED;
            } else {
            PG8_LDB(B0, 0, 0); PG8_SCHED; PG8_LDA(At, 0, 0); PG8_STAGE(PG8_SA(1, 1), a1 + hstep, voffA);
            PG8_WAIT_L(8); PG8_BAR; PG8_WAIT_L(0); PG8_MMA(0, 0, At, B0); PG8_BAR; PG8_SCHED;
            PG8_LDB(B1, 0, 1); PG8_STAGE(PG8_SB(0, 0), b2, voffB);
            PG8_BAR; PG8_WAIT_L(0); PG8_MMA(0, 1, At, B1); PG8_BAR;
            PG8_LDA(At, 0, 1); PG8_STAGE(PG8_SA(0, 0), a2, voffA);
            PG8_BAR; PG8_WAIT_L(0); PG8_MMA(1, 0, At, B0); PG8_BAR; PG8_SCHED;
            PG8_STAGE(PG8_SB(0, 1), b2 + hstep, voffB);
            PG8_WAIT_V(6); PG8_BAR; PG8_MMA(1, 1, At, B1); PG8_BAR;
            PG8_LDB(B0, 1, 0); PG8_SCHED; PG8_LDA(At, 1, 0); PG8_STAGE(PG8_SA(0, 1), a2 + hstep, voffA);
            PG8_WAIT_L(8); PG8_BAR; PG8_WAIT_L(0); PG8_MMA(0, 0, At, B0); PG8_BAR; PG8_SCHED;
            PG8_LDB(B1, 1, 1); PG8_STAGE(PG8_SB(1, 0), b3, voffB);
            PG8_BAR; PG8_WAIT_L(0); PG8_MMA(0, 1, At, B1); PG8_BAR;
            PG8_LDA(At, 1, 1); PG8_STAGE(PG8_SA(1, 0), a3, voffA);
            PG8_BAR; PG8_WAIT_L(0); PG8_MMA(1, 0, At, B0); PG8_BAR; PG8_SCHED;
            PG8_STAGE(PG8_SB(1, 1), b3 + hstep, voffB);
            PG8_WAIT_V(6); PG8_BAR; PG8_MMA(1, 1, At, B1); PG8_BAR;
            }
        }
        if constexpr (ALIGN_EPI) { if (wr == 0) PG8_BAR; }
        if constexpr (!Epi::AFTER_DRAIN) { E(acc, cur, wr, wc, fr, fq); S.done(cur); }
        if (!has_next) break;
#pragma unroll
        for (int a = 0; a < 2; ++a)
#pragma unroll
            for (int b = 0; b < 2; ++b)
#pragma unroll
                for (int m = 0; m < 4; ++m)
#pragma unroll
                    for (int n = 0; n < 2; ++n) acc[a][b][m][n] = (f32x4){0.f, 0.f, 0.f, 0.f};
        cur = nxt; cA = nA; cB = nB; ++ui;
        if constexpr (ALIGN_EPI) { if (wr == 1) PG8_BAR; }
    }
    PG8_WAIT_V(0);
    if constexpr (!ALIGN_EPI) { if (wr == 0) PG8_BAR; }
    PG8_BAR;
    if constexpr (Epi::AFTER_DRAIN) { E.fused(acc, cur, wr, wc, fr, fq, lds, wid, lane); S.done(cur); }
#undef PG8_SA
#undef PG8_SB
#undef PG8_STAGE
#undef PG8_LDA
#undef PG8_LDB
#undef PG8_MMA
#undef PG8_WAIT_V
#undef PG8_WAIT_L
#undef PG8_BAR
#undef PG8_SCHED
}
}
#ifndef PG8_SP2
#define PG8_SP2 true
#endif
#ifndef PG8_ALIGN
#define PG8_ALIGN true
#endif
constexpr int NWAVES = 8;
#ifndef MK_PER_PHASE
#define MK_PER_PHASE 1
#endif
constexpr int BATCH = 8, SEQ = 2048, D = 1024, FF = 4096, DEPTH = 4;
constexpr int M = BATCH * SEQ;
constexpr int NQKV = 3 * D;
constexpr int MODW = 6 * D;
constexpr float LN_EPS = 1e-5f, SUBLN_EPS = 1e-5f;
constexpr float DN_ALPHA = 1.681792830507429f;
constexpr float QSCALE = 0.18033688011112042f;
constexpr int NPHASE = 2 + 7 * DEPTH;

constexpr size_t MiB = 1u << 20;
constexpr size_t WS_CTL = 0, CTL_ZERO_BYTES = 1 * MiB;
constexpr size_t WS_MOD = 1 * MiB;
constexpr size_t WS_ROPE = 2 * MiB;
constexpr size_t WS_KPART = 2 * MiB + 512 * 1024;
constexpr size_t WS_XCH = 3 * MiB;
constexpr size_t WS_W = 8 * MiB, W_LAYER = 24 * MiB;
constexpr size_t WOFF_IN = 0, WOFF_O = 6 * MiB, WOFF_UP = 8 * MiB, WOFF_DN = 16 * MiB;
constexpr size_t WS_Q = 104 * MiB, WS_K = 136 * MiB, WS_V = 168 * MiB, WS_O = 200 * MiB;
constexpr size_t WS_H = 104 * MiB;
constexpr size_t WS_HM = 232 * MiB;
constexpr size_t WS_END = 264 * MiB;
static_assert(WS_V - WS_K == WS_K - WS_Q && WS_W + DEPTH * W_LAYER <= WS_Q && WS_H + (size_t)M * FF * 2 <= WS_HM && WS_HM + (size_t)M * D * 2 <= WS_END, "d_ws map");
constexpr int CW_TMO = 0, CW_CODE = 1;
constexpr int CW_BAR = 4096;
constexpr int CW_SEAM = 16384, SEAM_BANK = 128 * 64;

constexpr int RING_OFF = 0, RING_BYTES = 131072;
constexpr int LDSCTL_OFF = RING_BYTES, MISC_OFF = LDSCTL_OFF + 320;
constexpr int LDS_BYTES = 147456;
static_assert(MISC_OFF + 128 <= LDS_BYTES, "LDS map");

#define GAS __attribute__((address_space(1)))
#define LAS __attribute__((address_space(3)))
typedef unsigned short bf16;
typedef unsigned v4u __attribute__((ext_vector_type(4)));
typedef float f32x4 __attribute__((ext_vector_type(4)));
typedef short bf16x8 __attribute__((ext_vector_type(8)));
typedef GAS unsigned gu32;
typedef GAS unsigned long long gu64;
#define RLX_AGENT __ATOMIC_RELAXED, __HIP_MEMORY_SCOPE_AGENT
#define LDS_WAIT() asm volatile("s_waitcnt lgkmcnt(0)" ::: "memory")
#define VM_WAIT() asm volatile("s_waitcnt vmcnt(0)" ::: "memory")
__device__ __forceinline__ unsigned long long rt() { return __builtin_amdgcn_s_memrealtime(); }
__device__ __forceinline__ unsigned f2bf(float f) { unsigned u = __builtin_bit_cast(unsigned, f); return (u + 0x7fffu + ((u >> 16) & 1u)) >> 16; }
__device__ __forceinline__ unsigned pk2(float lo, float hi) { return f2bf(lo) | (f2bf(hi) << 16); }

#define XB_TMO      128
#define XB_XCNT(j)  (256  + 64 * (j))
#define XB_XSUB(j)  (1280 + 64 * (j))
#define XB_XGEN(j)  (2304 + 64 * (j))
#define XB_TOP      3328
#define XB_TOPGEN   3392
#define XCD_BAR_WORDS 3456
#define XB_SPIN_CAP (1u << 23)

__device__ __forceinline__ unsigned xb_ld(unsigned* p)              { return __hip_atomic_load(p, __ATOMIC_RELAXED, __HIP_MEMORY_SCOPE_AGENT); }
__device__ __forceinline__ unsigned xb_add(unsigned* p, unsigned v) { return __hip_atomic_fetch_add(p, v, __ATOMIC_RELAXED, __HIP_MEMORY_SCOPE_AGENT); }
__device__ __forceinline__ unsigned xb_xcc_id() { return (unsigned)__builtin_amdgcn_s_getreg((3 << 11) | 20) & 0xFu; }
#define XB_SPIN(cond, bar) do { unsigned _sp = 0; while (cond) { __builtin_amdgcn_s_sleep(1); \
    if ((++_sp & 255u) == 0u) { if (xb_ld(&(bar)[XB_TMO])) break; if (_sp > XB_SPIN_CAP) { atomicAdd(&(bar)[XB_TMO], 1u); break; } } } } while (0)

struct XcdBarrier {
    unsigned* bar; unsigned x;
    volatile LAS unsigned* st;
};

__device__ __forceinline__ XcdBarrier xcd_barrier_post(unsigned* bar, volatile LAS unsigned* st) {
    XcdBarrier b; b.bar = bar; b.x = xb_xcc_id(); b.st = st;
    if (threadIdx.x == 0) (void)xb_add(&bar[XB_XCNT(b.x)], 1u);
    return b;
}
__device__ __forceinline__ void xcd_barrier_complete(unsigned* bar, unsigned x, unsigned& nloc, unsigned& nx) {
    const unsigned G = gridDim.x * gridDim.y * gridDim.z;
    unsigned sum, cnt, mine, sp = 0u;
    for (;;) {
        sum = 0u; cnt = 0u; mine = 0u;
#pragma unroll
        for (unsigned j = 0; j < 16; ++j) { const unsigned c = xb_ld(&bar[XB_XCNT(j)]); sum += c; cnt += (c > 0u) ? 1u : 0u; mine = (j == x) ? c : mine; }
        if (sum == G) break;
        __builtin_amdgcn_s_sleep(1);
        if ((++sp & 255u) == 0u) { if (xb_ld(&bar[XB_TMO])) break; if (sp > XB_SPIN_CAP) { atomicAdd(&bar[XB_TMO], 1u); break; } }
    }
    nloc = mine > 0u ? mine : 1u; nx = cnt > 0u ? cnt : 1u;
}

__device__ __forceinline__ void xcd_barrier(const XcdBarrier& b) {
    asm volatile("s_waitcnt vmcnt(0)" ::: "memory");
    __syncthreads();
    if (threadIdx.x == 0) {
        unsigned* bar = b.bar;
        __builtin_amdgcn_s_waitcnt(0);
        unsigned nloc = b.st[0], nx = b.st[1];
        if (nloc == 0u) { xcd_barrier_complete(bar, b.x, nloc, nx); b.st[0] = nloc; b.st[1] = nx; }
        const unsigned old = xb_add(&bar[XB_XSUB(b.x)], 1u);
        const unsigned gen = old / nloc;
        if (old + 1u == (gen + 1u) * nloc) {
            __builtin_amdgcn_fence(__ATOMIC_RELEASE, "agent");
            asm volatile("s_waitcnt vmcnt(0)" ::: "memory");
            const unsigned og = xb_add(&bar[XB_TOP], 1u);
            const unsigned tg = og / nx;
            if (og + 1u == (tg + 1u) * nx) xb_add(&bar[XB_TOPGEN], 1u);
            else XB_SPIN(xb_ld(&bar[XB_TOPGEN]) == tg, bar);
            __builtin_amdgcn_fence(__ATOMIC_ACQUIRE, "agent");
            xb_add(&bar[XB_XGEN(b.x)], 1u);
            asm volatile("s_waitcnt vmcnt(0)" ::: "memory");
        } else {
            XB_SPIN(xb_ld(&bar[XB_XGEN(b.x)]) == gen, bar);
            __builtin_amdgcn_fence(__ATOMIC_ACQUIRE, "agent");
            asm volatile("s_waitcnt vmcnt(0)" ::: "memory");
        }
    }
    __syncthreads();
}

struct Args { const float* in[17]; float* out; unsigned char* ws; int ph_lo, ph_hi; };
struct Frame {
    LAS unsigned char* lds;
    volatile LAS unsigned* MISC;
    gu32* ctl;
    int tid, lane, wave;
    int vcu, G;
    const struct Args* a;
    unsigned char* ws;
    int z;
};
#define F_X (F.a->in[0 + F.z])
#define F_C (F.a->in[1 + F.z])
#define F_MOBA_W_IN (F.a->in[2 + F.z])
#define F_MOBA_W_OUT (F.a->in[3 + F.z])
#define F_DIFF_W_IN (F.a->in[4 + F.z])
#define F_DIFF_W_OUT (F.a->in[5 + F.z])
#define F_LAM_Q1 (F.a->in[6 + F.z])
#define F_LAM_K1 (F.a->in[7 + F.z])
#define F_LAM_Q2 (F.a->in[8 + F.z])
#define F_LAM_K2 (F.a->in[9 + F.z])
#define F_SUBLN_G (F.a->in[10 + F.z])
#define F_ADA_W (F.a->in[11 + F.z])
#define F_ADA_B (F.a->in[12 + F.z])
#define F_LN_G (F.a->in[13 + F.z])
#define F_LN_B (F.a->in[14 + F.z])
#define F_W_UP (F.a->in[15 + F.z])
#define F_W_DOWN (F.a->in[16 + F.z])
#define F_OUT ((&F.a->out)[F.z])
#define F_MOD ((float*)(F.ws + WS_MOD))
#define F_ROPE ((float*)(F.ws + WS_ROPE))
#define F_KPART ((float*)(F.ws + WS_KPART))
#define F_Q ((bf16*)(F.ws + WS_Q))
#define F_K ((bf16*)(F.ws + WS_K))
#define F_V ((bf16*)(F.ws + WS_V))
#define F_O ((bf16*)(F.ws + WS_O))
#define F_H ((bf16*)(F.ws + WS_H))
#define F_HM ((bf16*)(F.ws + WS_HM))
__device__ __forceinline__ bf16* w_in_t(Frame& F, int l) { return (bf16*)(F.ws + WS_W + (size_t)l * W_LAYER + WOFF_IN); }
__device__ __forceinline__ bf16* w_o_t(Frame& F, int l)  { return (bf16*)(F.ws + WS_W + (size_t)l * W_LAYER + WOFF_O); }
__device__ __forceinline__ bf16* w_up_t(Frame& F, int l) { return (bf16*)(F.ws + WS_W + (size_t)l * W_LAYER + WOFF_UP); }
__device__ __forceinline__ bf16* w_dn_t(Frame& F, int l) { return (bf16*)(F.ws + WS_W + (size_t)l * W_LAYER + WOFF_DN); }

__device__ __forceinline__ float wave_sum(float v) {
#pragma unroll
    for (int o = 1; o < 64; o <<= 1) v += __shfl_xor(v, o);
    return v;
}
__device__ __forceinline__ float wave_max(float v) {
#pragma unroll
    for (int o = 1; o < 64; o <<= 1) v = fmaxf(v, __shfl_xor(v, o));
    return v;
}
__device__ __forceinline__ float bf2f(bf16 h) { return __builtin_bit_cast(float, (unsigned)h << 16); }
__device__ __forceinline__ void p0_transpose_item(const float* W, int K, int N, bf16* WT, int row_off, LAS float* scr, int item, int lane) {
    const int nblk = N / 32, kb = item / nblk, nb = item % nblk, k0 = 64 * kb, n0 = 32 * nb;
#pragma unroll 8
    for (int i = 0; i < 32; ++i) { const int kk = 2 * i + (lane >> 5); scr[kk * 33 + (lane & 31)] = W[(size_t)(k0 + kk) * N + n0 + (lane & 31)]; }
    LDS_WAIT(); asm volatile("" ::: "memory");
    const int c = lane & 7;
#pragma unroll
    for (int j = 0; j < 4; ++j) { const int n = (lane >> 3) + 8 * j; const LAS float* s = scr + (8 * c) * 33 + n;
        v4u o; o.x = pk2(s[0 * 33], s[1 * 33]); o.y = pk2(s[2 * 33], s[3 * 33]); o.z = pk2(s[4 * 33], s[5 * 33]); o.w = pk2(s[6 * 33], s[7 * 33]);
        *(GAS v4u*)(WT + (size_t)(row_off + n0 + n) * K + k0 + 8 * c) = o; }
    LDS_WAIT(); asm volatile("" ::: "memory");
}
__device__ __forceinline__ void sincos_d(double a, double& s, double& c) {
    const double kq = rint(a * 0.63661977236758134308);
    double r = fma(-kq, 1.57079632679489655800, a); r = fma(-kq, 6.12323399573676603587e-17, r);
    const double r2 = r * r;
    double sp = -1.0 / 1307674368000.0; sp = fma(sp, r2, 1.0 / 6227020800.0); sp = fma(sp, r2, -1.0 / 39916800.0); sp = fma(sp, r2, 1.0 / 362880.0); sp = fma(sp, r2, -1.0 / 5040.0); sp = fma(sp, r2, 1.0 / 120.0); sp = fma(sp, r2, -1.0 / 6.0); sp = fma(sp, r2, 1.0);
    const double sr = r * sp;
    double cp = 1.0 / 20922789888000.0; cp = fma(cp, r2, -1.0 / 87178291200.0); cp = fma(cp, r2, 1.0 / 479001600.0); cp = fma(cp, r2, -1.0 / 3628800.0); cp = fma(cp, r2, 1.0 / 40320.0); cp = fma(cp, r2, -1.0 / 720.0); cp = fma(cp, r2, 1.0 / 24.0); cp = fma(cp, r2, -0.5); cp = fma(cp, r2, 1.0);
    const int q = (int)kq & 3;
    s = (q == 0) ? sr : (q == 1) ? cp : (q == 2) ? -sr : -cp;
    c = (q == 0) ? cp : (q == 1) ? -sr : (q == 2) ? -cp : sr;
}
__device__ __forceinline__ float rope_inv(int j) {
    return j == 0 ? 1.0f : j == 1 ? 0.19392274474868576f : j == 2 ? 0.03760603093086393f : j == 3 ? 0.007292664737217109f : j == 4 ? 0.001414213562373095f
         : j == 5 ? 0.0002742481756762073f : j == 6 ? 5.318295896944988e-05f : 1.031338537721246e-05f;
}
__device__ __forceinline__ void p0_prologue(Frame& F) {
    LAS float* scr = (LAS float*)(F.lds + RING_OFF + F.wave * 16384);
    const int gw = F.vcu * NWAVES + F.wave, NGW = F.G * NWAVES;
    constexpr int I_IN = (D / 64) * (NQKV / 32), I_O = (D / 64) * (D / 32), I_UP = (D / 64) * (FF / 32), I_DN = (FF / 64) * (D / 32), PER = I_IN + I_O + I_UP + I_DN;
    for (int it = gw; it < DEPTH * PER; it += NGW) {
        const int l = it / PER, j = l >> 1; int r = it % PER;
        if (r < I_IN) { const float* src = ((l & 1) ? F_DIFF_W_IN : F_MOBA_W_IN) + (size_t)j * D * NQKV; p0_transpose_item(src, D, NQKV, w_in_t(F, l), 0, scr, r, F.lane); continue; } r -= I_IN;
        if (r < I_O)  { const float* src = ((l & 1) ? F_DIFF_W_OUT : F_MOBA_W_OUT) + (size_t)j * D * D; p0_transpose_item(src, D, D, w_o_t(F, l), 0, scr, r, F.lane); continue; } r -= I_O;
        if (r < I_UP) { p0_transpose_item(F_W_UP + (size_t)l * D * FF, D, FF, w_up_t(F, l), 0, scr, r, F.lane); continue; } r -= I_UP;
        p0_transpose_item(F_W_DOWN + (size_t)l * FF * D, FF, D, w_dn_t(F, l), 0, scr, r, F.lane);
    }
    for (int e = F.vcu * (NWAVES * 64) + F.tid; e < SEQ * 8; e += F.G * NWAVES * 64) {
        const int pos = e >> 3, j = e & 7; const float ang = (float)pos * rope_inv(j);
        double s, c; sincos_d((double)ang, s, c);
        F_ROPE[pos * 16 + j] = (float)c; F_ROPE[pos * 16 + 8 + j] = (float)s;
    }
    __syncthreads();
    LAS float* sl = (LAS float*)(F.lds + RING_OFF);
    LAS float* red = (LAS float*)(F.lds + RING_OFF + 32768);
    for (int i = F.tid; i < BATCH * D; i += NWAVES * 64) { const float cv = F_C[i]; sl[i] = cv / (1.0f + expf(-cv)); }
    __syncthreads();
    for (int it = F.vcu; it < DEPTH * (MODW / 64); it += F.G) {
        const int l = it / (MODW / 64), ch = it % (MODW / 64);
        const float* w = F_ADA_W + (size_t)l * D * MODW + (size_t)(F.wave * 128) * MODW + ch * 64 + F.lane;
        float a[8];
#pragma unroll
        for (int b = 0; b < 8; ++b) a[b] = 0.f;
#pragma unroll 8
        for (int d = 0; d < 128; ++d) { const float wv = w[(size_t)d * MODW];
#pragma unroll
            for (int b = 0; b < 8; ++b) a[b] += sl[b * D + F.wave * 128 + d] * wv; }
#pragma unroll
        for (int b = 0; b < 8; ++b) red[(F.wave * 8 + b) * 64 + F.lane] = a[b];
        __syncthreads();
        { const int b = F.tid >> 6, cl = F.tid & 63; float s = F_ADA_B[l * MODW + ch * 64 + cl];
#pragma unroll
          for (int w8 = 0; w8 < 8; ++w8) s += red[(w8 * 8 + b) * 64 + cl];
          F_MOD[(size_t)(l * BATCH + b) * MODW + ch * 64 + cl] = s; }
        __syncthreads();
    }
}
__device__ __forceinline__ void p1_hm0(Frame& F) {
    const int gw = F.vcu * NWAVES + F.wave, NGW = F.G * NWAVES;
    for (int m = gw; m < M; m += NGW) {
        const int b = m >> 11; const float* md = F_MOD + (size_t)b * MODW;
        const GAS f32x4* xr = (const GAS f32x4*)(F_X + (size_t)m * D) + F.lane;
        GAS unsigned long long* o8 = (GAS unsigned long long*)(F_HM + (size_t)m * D) + F.lane;
#pragma unroll
        for (int j = 0; j < 4; ++j) { const f32x4 v = xr[64 * j]; const int col = 4 * F.lane + 256 * j;
            const f32x4 sh = *(const f32x4*)(md + col), sc = *(const f32x4*)(md + 1024 + col);
            const f32x4 h = v * (sc + 1.0f) + sh;
            o8[64 * j] = (unsigned long long)pk2(h.x, h.y) | ((unsigned long long)pk2(h.z, h.w) << 32); }
    }
}
__device__ __forceinline__ void ln_rows_phase(Frame& F, float* x, const float* g, const float* bt, const float* shift, const float* scale, bf16* hm) {
    const int gw = F.vcu * NWAVES + F.wave, NGW = F.G * NWAVES;
    for (int m = gw; m < M; m += NGW) {
        const int b = m >> 11;
        GAS f32x4* xr = (GAS f32x4*)(x + (size_t)m * D) + F.lane;
        f32x4 v[4]; float s = 0.f;
#pragma unroll
        for (int j = 0; j < 4; ++j) { v[j] = xr[64 * j]; s += (v[j].x + v[j].y) + (v[j].z + v[j].w); }
        const float mean = wave_sum(s) * (1.f / D); float s2 = 0.f;
#pragma unroll
        for (int j = 0; j < 4; ++j) { v[j] = v[j] - mean; s2 += (v[j].x * v[j].x + v[j].y * v[j].y) + (v[j].z * v[j].z + v[j].w * v[j].w); }
        const float rstd = 1.f / sqrtf(wave_sum(s2) * (1.f / D) + LN_EPS);
        GAS unsigned long long* o8 = (GAS unsigned long long*)(hm + (size_t)m * D) + F.lane;
#pragma unroll
        for (int j = 0; j < 4; ++j) { const int col = 4 * F.lane + 256 * j;
            const f32x4 xn = (v[j] * rstd) * *(const f32x4*)(g + col) + *(const f32x4*)(bt + col);
            xr[64 * j] = xn;
            if (hm) { const f32x4 h = xn * (*(const f32x4*)(scale + (size_t)b * MODW + col) + 1.0f) + *(const f32x4*)(shift + (size_t)b * MODW + col);
                o8[64 * j] = (unsigned long long)pk2(h.x, h.y) | ((unsigned long long)pk2(h.z, h.w) << 32); } }
    }
}
template <int DV>
__device__ __forceinline__ void naive_attend(const bf16* qrow, const bf16* Kb, const bf16* Vb, const int (&rs)[4], const int (&rc)[4], int nr, LAS float* sc, int lane, float& o0, float& o1) {
    unsigned qp[32];
#pragma unroll
    for (int i = 0; i < 8; ++i) { const v4u t = *(const v4u*)(qrow + 8 * i); qp[4 * i] = t.x; qp[4 * i + 1] = t.y; qp[4 * i + 2] = t.z; qp[4 * i + 3] = t.w; }
    float mx = -INFINITY; int off = 0;
#pragma unroll
    for (int r = 0; r < 4; ++r) if (r < nr) {
        for (int i = lane; i < rc[r]; i += 64) {
            const v4u* kp = (const v4u*)(Kb + (size_t)(rs[r] + i) * 1024);
            float dot = 0.f;
#pragma unroll
            for (int c8 = 0; c8 < 8; ++c8) { const v4u kk = kp[c8];
#pragma unroll
                for (int e = 0; e < 4; ++e) dot += __builtin_bit_cast(float, kk[e] << 16) * __builtin_bit_cast(float, qp[c8 * 4 + e] << 16) + __builtin_bit_cast(float, kk[e] & 0xffff0000u) * __builtin_bit_cast(float, qp[c8 * 4 + e] & 0xffff0000u); }
            sc[off + i] = dot; mx = fmaxf(mx, dot);
        }
        off += rc[r];
    }
    mx = wave_max(mx);
    LDS_WAIT();
    float sum = 0.f; o0 = 0.f; o1 = 0.f; off = 0;
#pragma unroll
    for (int r = 0; r < 4; ++r) if (r < nr) {
        const bf16* vp = Vb + (size_t)rs[r] * 1024 + lane;
#pragma unroll 4
        for (int i = 0; i < rc[r]; ++i) { const float p = __builtin_amdgcn_exp2f(sc[off + i] - mx); sum += p; o0 += p * bf2f(vp[(size_t)i * 1024]); if (DV == 128) o1 += p * bf2f(vp[(size_t)i * 1024 + 64]); }
        off += rc[r];
    }
    const float inv = 1.0f / sum; o0 *= inv; o1 *= inv;
    LDS_WAIT();
}
__device__ __forceinline__ void moba_naive_phase(Frame& F) {
    const int gw = F.vcu * NWAVES + F.wave, NGW = F.G * NWAVES; const int lane = F.lane;
    LAS float* sc = (LAS float*)(F.lds + RING_OFF) + F.wave * 2048;
    for (int it = gw; it < BATCH * 16 * SEQ; it += NGW) {
        const int bh = it & 127, s = it >> 7, b = bh >> 4, h = bh & 15, jq = s >> 8;
        const size_t rowb = (size_t)b * SEQ;
        const bf16* qrow = F_Q + (rowb + s) * 1024 + h * 64;
        const float qd = bf2f(qrow[lane]);
        float g[8];
#pragma unroll
        for (int n = 0; n < 8; ++n) { g[n] = -INFINITY;
            if (n < jq) { const float* kp = F_KPART + (size_t)((b * 8 + n) * 2) * 1024 + h * 64 + lane; g[n] = wave_sum(qd * (kp[0] + kp[1024])); } }
        unsigned picked = 0u; int selblk[3];
#pragma unroll
        for (int t = 0; t < 3; ++t) { float best = -INFINITY; int bi = -1;
#pragma unroll
            for (int n = 0; n < 8; ++n) { const bool ok = (n < jq) && !((picked >> n) & 1u) && (bi < 0 || g[n] > best); if (ok) { best = g[n]; bi = n; } }
            selblk[t] = bi; if (bi >= 0) picked |= 1u << bi; }
        int rs[4], rc[4];
        rs[0] = jq * 256; rc[0] = s - jq * 256 + 1;
#pragma unroll
        for (int t = 0; t < 3; ++t) { rs[t + 1] = selblk[t] * 256; rc[t + 1] = 256; }
        const int nr = 1 + (jq < 3 ? jq : 3);
        float o0, o1;
        naive_attend<64>(qrow, F_K + rowb * 1024 + h * 64, F_V + rowb * 1024 + h * 64, rs, rc, nr, sc, lane, o0, o1);
        F_O[(rowb + s) * 1024 + h * 64 + lane] = (bf16)f2bf(o0);
    }
}
__device__ __forceinline__ void diff_naive_phase(Frame& F, int j, float lambda_init) {
    const int gw = F.vcu * NWAVES + F.wave, NGW = F.G * NWAVES; const int lane = F.lane;
    LAS float* sc = (LAS float*)(F.lds + RING_OFF) + F.wave * 2048;
    const float lam = expf(wave_sum(F_LAM_Q1[j * 64 + lane] * F_LAM_K1[j * 64 + lane])) - expf(wave_sum(F_LAM_Q2[j * 64 + lane] * F_LAM_K2[j * 64 + lane])) + lambda_init;
    const float g0 = F_SUBLN_G[j * 128 + lane] * (1.0f - lambda_init), g1 = F_SUBLN_G[j * 128 + 64 + lane] * (1.0f - lambda_init);
    for (int it = gw; it < BATCH * 8 * SEQ; it += NGW) {
        const int bh = it & 63, s = it >> 6, b = bh >> 3, h = bh & 7;
        const size_t rowb = (size_t)b * SEQ;
        int rs[4], rc[4]; rs[0] = 0; rc[0] = s + 1; rs[1] = rs[2] = rs[3] = 0; rc[1] = rc[2] = rc[3] = 0;
        float a0, a1, b0, b1;
        naive_attend<128>(F_Q + (rowb + s) * 1024 + h * 128, F_K + rowb * 1024 + h * 128, F_V + rowb * 1024 + h * 128, rs, rc, 1, sc, lane, a0, a1);
        naive_attend<128>(F_Q + (rowb + s) * 1024 + h * 128 + 64, F_K + rowb * 1024 + h * 128 + 64, F_V + rowb * 1024 + h * 128, rs, rc, 1, sc, lane, b0, b1);
        const float o0 = a0 - lam * b0, o1 = a1 - lam * b1;
        const float r = 1.0f / sqrtf(wave_sum(o0 * o0 + o1 * o1) * (1.0f / 128.0f) + SUBLN_EPS);
        F_O[(rowb + s) * 1024 + h * 128 + lane] = (bf16)f2bf(o0 * r * g0);
        F_O[(rowb + s) * 1024 + h * 128 + 64 + lane] = (bf16)f2bf(o1 * r * g1);
    }
}

__global__ void __launch_bounds__(NWAVES * 64, 2) mk_fwd(Args args) {
    extern __shared__ __attribute__((aligned(16))) unsigned char lds[];
    Frame F;
    F.lds = (LAS unsigned char*)lds;
    F.MISC = (volatile LAS unsigned*)(F.lds + MISC_OFF);
    F.tid = threadIdx.x; F.lane = F.tid & 63; F.wave = __builtin_amdgcn_readfirstlane(F.tid >> 6);
    F.G = gridDim.x; { const int bx = blockIdx.x; F.vcu = (F.G % 8 == 0) ? (bx % 8) * (F.G / 8) + bx / 8 : bx; }
    unsigned char* ws = args.ws; F.ws = ws;
    F.ctl = (gu32*)(ws + WS_CTL);
    F.a = &args;
    for (int u = F.tid; u < (LDS_BYTES - LDSCTL_OFF) / 4; u += NWAVES * 64) ((LAS unsigned*)(F.lds + LDSCTL_OFF))[u] = 0u;
    __syncthreads();
    const int lo = args.ph_lo, hi = args.ph_hi;
    XcdBarrier bar; bar.bar = (unsigned*)(F.ctl + CW_BAR); bar.x = 0; bar.st = nullptr;
    if (hi - lo > 1) bar = xcd_barrier_post((unsigned*)(F.ctl + CW_BAR), F.MISC + 8);
    for (int ph = lo; ph < hi; ++ph) {
        { int t = threadIdx.x; asm volatile("" : "+v"(t)); F.tid = t; F.lane = t & 63; F.wave = __builtin_amdgcn_readfirstlane(t >> 6); }
        { unsigned char* w_ = args.ws; asm volatile("" : "+s"(w_)); F.ws = w_; int z_ = 0; asm volatile("" : "+s"(z_)); F.z = z_; }
        if (ph == 0) p0_prologue(F);
        else if (ph == 1) p1_hm0(F);
        else {
            const int l = (ph - 2) / 7, kind = (ph - 2) % 7; const int jm = l >> 1; const bool is_diff = (l & 1) != 0;
            const float* modl = F_MOD + (size_t)l * BATCH * MODW;
            if (kind == 0) {
                pg8::Gemm g{F_HM, w_in_t(F, l), M, NQKV, D}; pg8::StaticOrder S; S.init(M, NQKV, F.G, (int)blockIdx.x);
                pg8::EpiQKV E{F_Q, (size_t)(WS_K - WS_Q) / 2, F_ROPE, is_diff ? nullptr : F_KPART, QSCALE};
                pg8::gemm_phase<pg8::EpiQKV, pg8::StaticOrder, PG8_ALIGN, PG8_SP2>(F.lds + RING_OFF, g, S, E);
            } else if (kind == 1) {
                if (is_diff) diff_naive_phase(F, jm, l == 1 ? 0.35550906759096934f : 0.5560582041556406f);
                else moba_naive_phase(F);
            } else if (kind == 2) {
                pg8::Gemm g{F_O, w_o_t(F, l), M, D, D}; pg8::StaticOrder S; S.init(M, D, F.G, (int)blockIdx.x);
                pg8::EpiResid E{l == 0 ? F_X : (const float*)F_OUT, F_OUT, modl + 2048, DN_ALPHA};
                pg8::gemm_phase<pg8::EpiResid, pg8::StaticOrder, PG8_ALIGN, PG8_SP2>(F.lds + RING_OFF, g, S, E);
            } else if (kind == 3) {
                ln_rows_phase(F, F_OUT, F_LN_G + (size_t)(l * 2 + 0) * D, F_LN_B + (size_t)(l * 2 + 0) * D, modl + 3072, modl + 4096, F_HM);
            } else if (kind == 4) {
                pg8::Gemm g{F_HM, w_up_t(F, l), M, FF, D}; pg8::StaticOrder S; S.init(M, FF, F.G, (int)blockIdx.x);
                pg8::EpiSqRelu E{F_H, FF};
                pg8::gemm_phase<pg8::EpiSqRelu, pg8::StaticOrder, PG8_ALIGN, PG8_SP2>(F.lds + RING_OFF, g, S, E);
            } else if (kind == 5) {
                pg8::Gemm g{F_H, w_dn_t(F, l), M, D, FF}; pg8::StaticOrder S; S.init(M, D, F.G, (int)blockIdx.x);
                pg8::EpiResid E{F_OUT, F_OUT, modl + 5120, DN_ALPHA};
                pg8::gemm_phase<pg8::EpiResid, pg8::StaticOrder, PG8_ALIGN, PG8_SP2>(F.lds + RING_OFF, g, S, E);
            } else {
                const float* modn = modl + (size_t)BATCH * MODW;
                ln_rows_phase(F, F_OUT, F_LN_G + (size_t)(l * 2 + 1) * D, F_LN_B + (size_t)(l * 2 + 1) * D, modn + 0, modn + 1024, (l + 1 < DEPTH) ? F_HM : (bf16*)nullptr);
            }
        }
        if (ph + 1 < hi) xcd_barrier(bar);
    }
}

extern "C" void kernel_launch(void* const* d_in, const int* in_sizes, int n_in, void* d_out, int out_size, void* d_ws, size_t ws_size, hipStream_t stream) {
    static int grid = 0;
    if (grid == 0) {
        if (n_in != 17 || in_sizes[0] != M * D || out_size != M * D || ws_size < WS_END) { fprintf(stderr, "kernel_launch: built for 17 inputs, x and out of %d floats, >= %zu bytes of workspace; got n_in %d, in0 %d, out %d, ws %zu; nothing launched\n", M * D, (size_t)WS_END, n_in, n_in > 0 ? in_sizes[0] : -1, out_size, ws_size); grid = -1; return; }
        int dev = 0, cus = 0, per_cu = 0;
        if (hipGetDevice(&dev) != hipSuccess || hipDeviceGetAttribute(&cus, hipDeviceAttributeMultiprocessorCount, dev) != hipSuccess) { fprintf(stderr, "kernel_launch: hipGetDevice / hipDeviceGetAttribute failed; nothing launched\n"); grid = -1; return; }
        if (hipFuncSetAttribute((const void*)mk_fwd, hipFuncAttributeMaxDynamicSharedMemorySize, LDS_BYTES) != hipSuccess) { fprintf(stderr, "kernel_launch: hipFuncSetAttribute failed\n"); grid = -1; return; }
        if (hipOccupancyMaxActiveBlocksPerMultiprocessor(&per_cu, (const void*)mk_fwd, NWAVES * 64, LDS_BYTES) != hipSuccess || per_cu < 1)
            fprintf(stderr, "kernel_launch: note: the occupancy query reports %d workgroups per CU\n", per_cu);
        (void)hipGetLastError();
        grid = cus;
        if (grid != 256) fprintf(stderr, "kernel_launch: launching %d workgroups (built for 256 CUs)\n", grid);
    }
    if (grid < 0) return;
    if (hipMemsetAsync((char*)d_ws + WS_CTL, 0, CTL_ZERO_BYTES, stream) != hipSuccess) { fprintf(stderr, "kernel_launch: hipMemsetAsync of the control words failed; nothing launched\n"); return; }
    Args a{};
    for (int i = 0; i < 17; ++i) a.in[i] = (const float*)d_in[i];
    a.out = (float*)d_out; a.ws = (unsigned char*)d_ws;
#if MK_PER_PHASE
    for (int p = 0; p < NPHASE; ++p) { a.ph_lo = p; a.ph_hi = p + 1; hipLaunchKernelGGL(mk_fwd, dim3(grid), dim3(NWAVES * 64), LDS_BYTES, stream, a); }
#else
    a.ph_lo = 0; a.ph_hi = NPHASE;
    hipLaunchKernelGGL(mk_fwd, dim3(grid), dim3(NWAVES * 64), LDS_BYTES, stream, a);
#endif
    const hipError_t le = hipPeekAtLastError();
    if (le != hipSuccess) fprintf(stderr, "kernel_launch: launch failed: %s (grid %d x %d threads, %d B LDS)\n", hipGetErrorName(le), grid, NWAVES * 64, LDS_BYTES);
}
```

```cpp
#include <hip/hip_runtime.h>
#include <cstdio>
#include <cstdint>
#include <cmath>
namespace pg8 {
#define PG8_LAS __attribute__((address_space(3)))
typedef unsigned short bf16_t;
typedef short bf16x8 __attribute__((ext_vector_type(8)));
typedef float f32x4 __attribute__((ext_vector_type(4)));
typedef unsigned u32x4 __attribute__((ext_vector_type(4)));
constexpr int BM = 256, BK = 64, HALF = 128, HTB = HALF * BK * 2  , STAGE_BYTES = 8 * HTB, NXCD = 8, WGM = 8;

__host__ __device__ __forceinline__ int lds_byte(int r, int c) { const int st = (r >> 4) * 2 + (c >> 5), rr = r & 15, cc = c & 31, ob = rr * 64 + cc * 2; return st * 1024 + (ob ^ (((ob >> 9) & 1) << 5)); }
__host__ __device__ __forceinline__ void stage_rc(int b, int& R, int& C) { const int st = b / 1024, sb = b % 1024, swz = sb ^ (((sb >> 9) & 1) << 5); R = (st >> 1) * 16 + swz / 64; C = (st & 1) * 32 + (swz % 64) / 2; }
__host__ __device__ __forceinline__ int perm32(int rho) { const int n = rho >> 4, i = rho & 15; return 8 * (i >> 2) + 4 * n + (i & 3); }

struct Unit { int pm, pn; };
struct Gemm { const bf16_t* A; const bf16_t* Bt; int M, N, K; };

struct StaticOrder {
    int nM, nN, nwg, G, c;
    __host__ __device__ void init(int M, int N, int G_, int c_) { nM = M / BM; nN = N / BM; nwg = nM * nN; G = G_; c = c_; }
    __host__ __device__ bool next(int i, Unit& u) const {
        const long L = (long)i * G + c; if (L >= nwg) return false;
        int wgid = (int)L; { const int q = nwg / NXCD, r = nwg % NXCD, xcd = wgid % NXCD, off = wgid / NXCD; wgid = (xcd < r ? xcd * (q + 1) : r * (q + 1) + (xcd - r) * q) + off; }
        const int nig = WGM * nN, gid = wgid / nig, fm = gid * WGM, gsz = (nM - fm) < WGM ? (nM - fm) : WGM;
        u.pm = fm + ((wgid % nig) % gsz); u.pn = (wgid % nig) / gsz; return true;
    }
    __device__ __forceinline__ void a_ready(const Unit&) const {}
    __device__ __forceinline__ void done(const Unit&) const {}
};

__device__ __forceinline__ unsigned cvt_pk_bf16(float lo, float hi) { unsigned r; asm volatile("v_cvt_pk_bf16_f32 %0, %1, %2" : "=v"(r) : "v"(lo), "v"(hi)); return r; }
typedef float f32x2 __attribute__((ext_vector_type(2)));
struct EpiQKV {
    static constexpr bool PERM = true, AFTER_DRAIN = false;
    bf16_t* Q; size_t tstride;
    const float* rope;
    float* kpart;
    float qscale;
    __device__ __forceinline__ void operator()(const f32x4 (&acc)[2][2][4][2], const Unit& u, int wr, int wc, int fr, int fq) const {
        asm volatile("" : "+v"(fr), "+v"(fq));
        const int t = u.pn >> 2;
        bf16_t* base = Q + (size_t)t * tstride;
        const int colt = (u.pn & 3) * BM;
        const int col0 = colt + wc * 32 + 8 * fq;
        const float sc = (t == 0) ? qscale : 1.f;
        const bool do_rope = (t < 2) && ((wc & 1) == 0);
        const bool do_ksum = (t == 1) && (kpart != nullptr);
        const float sg = (fq == 0) ? -1.f : 1.f;
        float ks[2][8];
#pragma unroll
        for (int bj = 0; bj < 2; ++bj)
#pragma unroll
            for (int e = 0; e < 8; ++e) ks[bj][e] = 0.f;
#pragma unroll
        for (int ai = 0; ai < 2; ++ai)
#pragma unroll
            for (int m = 0; m < 4; ++m) {
                const int row = u.pm * BM + ai * HALF + wr * 64 + m * 16 + fr;
                const int pos = row & 2047;
                bf16_t* rowp = base + (size_t)row * 1024 + col0;
                f32x4 c0 = {1.f, 1.f, 1.f, 1.f}, c1 = c0, s0 = {0.f, 0.f, 0.f, 0.f}, s1 = s0;
                if (do_rope && fq < 2) { const float* cs = rope + pos * 16; c0 = *(const f32x4*)(cs); c1 = *(const f32x4*)(cs + 4); s0 = *(const f32x4*)(cs + 8); s1 = *(const f32x4*)(cs + 12); }
#pragma unroll
                for (int bj = 0; bj < 2; ++bj) {
                    f32x4 v0 = acc[ai][bj][m][0], v1 = acc[ai][bj][m][1];
                    if (do_rope) {
                        f32x4 p0, p1;
#pragma unroll
                        for (int e = 0; e < 4; ++e) { p0[e] = __shfl_xor(v0[e], 16); p1[e] = __shfl_xor(v1[e], 16); }
                        v0 = v0 * c0 + (p0 * s0) * sg; v1 = v1 * c1 + (p1 * s1) * sg;
                    }
                    if (do_ksum) {
#pragma unroll
                        for (int e = 0; e < 4; ++e) { ks[bj][e] += v0[e]; ks[bj][4 + e] += v1[e]; }
                    }
                    v0 = v0 * sc; v1 = v1 * sc;
                    u32x4 w; w.x = cvt_pk_bf16(v0[0], v0[1]); w.y = cvt_pk_bf16(v0[2], v0[3]); w.z = cvt_pk_bf16(v1[0], v1[1]); w.w = cvt_pk_bf16(v1[2], v1[3]);
                    *(u32x4*)(rowp + bj * HALF) = w;
                }
            }
        if (do_ksum) {
#pragma unroll
            for (int bj = 0; bj < 2; ++bj)
#pragma unroll
                for (int e = 0; e < 8; ++e) { float v = ks[bj][e]; v += __shfl_xor(v, 1); v += __shfl_xor(v, 2); v += __shfl_xor(v, 4); v += __shfl_xor(v, 8); ks[bj][e] = v; }
            if (fr == 0) {
                float* kp = kpart + ((size_t)(u.pm * 2 + wr)) * 1024 + col0;
#pragma unroll
                for (int bj = 0; bj < 2; ++bj) { *(f32x4*)(kp + bj * HALF) = (f32x4){ks[bj][0], ks[bj][1], ks[bj][2], ks[bj][3]}; *(f32x4*)(kp + bj * HALF + 4) = (f32x4){ks[bj][4], ks[bj][5], ks[bj][6], ks[bj][7]}; }
            }
        }
    }
};
struct EpiSqRelu {
    static constexpr bool PERM = true, AFTER_DRAIN = false;
    bf16_t* O; int ldc;
    __device__ __forceinline__ void operator()(const f32x4 (&acc)[2][2][4][2], const Unit& u, int wr, int wc, int fr, int fq) const {
        asm volatile("" : "+v"(fr), "+v"(fq));
        const int row0 = u.pm * BM + wr * 64 + fr; const int col0 = u.pn * BM + wc * 32 + 8 * fq;
#pragma unroll
        for (int ai = 0; ai < 2; ++ai)
#pragma unroll
            for (int m = 0; m < 4; ++m) { bf16_t* rowp = O + (size_t)(row0 + ai * HALF + m * 16) * ldc + col0;
#pragma unroll
                for (int bj = 0; bj < 2; ++bj) { f32x4 v0 = acc[ai][bj][m][0], v1 = acc[ai][bj][m][1];
#pragma unroll
                    for (int e = 0; e < 4; ++e) { const float a = fmaxf(v0[e], 0.f), b = fmaxf(v1[e], 0.f); v0[e] = a * a; v1[e] = b * b; }
                    u32x4 w; w.x = cvt_pk_bf16(v0[0], v0[1]); w.y = cvt_pk_bf16(v0[2], v0[3]); w.z = cvt_pk_bf16(v1[0], v1[1]); w.w = cvt_pk_bf16(v1[2], v1[3]);
                    *(u32x4*)(rowp + bj * HALF) = w; } }
    }
};
struct EpiResid {
    static constexpr bool PERM = false, AFTER_DRAIN = false;
    const float* xin; float* out; const float* gate; float alpha;
    __device__ __forceinline__ void operator()(const f32x4 (&acc)[2][2][4][2], const Unit& u, int wr, int wc, int fr, int fq) const {
        asm volatile("" : "+v"(fr), "+v"(fq));
        const int col0 = u.pn * BM + wc * 32 + 4 * fq; const int b = u.pm >> 3;
        f32x4 g[2][2];
#pragma unroll
        for (int bj = 0; bj < 2; ++bj)
#pragma unroll
            for (int n = 0; n < 2; ++n) g[bj][n] = *(const f32x4*)(gate + b * 6144 + col0 + bj * HALF + n * 16) + 1.0f;
#pragma unroll
        for (int ai = 0; ai < 2; ++ai)
#pragma unroll
            for (int m = 0; m < 4; ++m) { const size_t off = (size_t)(u.pm * BM + ai * HALF + wr * 64 + m * 16 + fr) * 1024 + col0;
#pragma unroll
                for (int bj = 0; bj < 2; ++bj)
#pragma unroll
                    for (int n = 0; n < 2; ++n) { const f32x4 xv = *(const f32x4*)(xin + off + bj * HALF + n * 16);
                        *(f32x4*)(out + off + bj * HALF + n * 16) = xv * alpha + g[bj][n] * acc[ai][bj][m][n]; } }
    }
};

template <class Epi, class Sched, bool ALIGN_EPI = false, bool SP2 = false>
__device__ __forceinline__ void gemm_phase(PG8_LAS unsigned char* lds, const Gemm g, const Sched& S, const Epi& E) {
    int tid_l = threadIdx.x; asm volatile("" : "+v"(tid_l));
    const int tid = tid_l, wid = __builtin_amdgcn_readfirstlane(tid >> 6), lane = tid & 63, wr = wid >> 2, wc = wid & 3, fr = lane & 15, fq = lane >> 4;
    const int K = g.K, nt = K / BK;
    unsigned voffA[2], voffB[2];
#pragma unroll
    for (int i = 0; i < 2; ++i) { int R, C; stage_rc(tid * 16 + i * 8192, R, C); const int Rb = Epi::PERM ? ((R & ~31) + perm32(R & 31)) : R;
        voffA[i] = (unsigned)(R * K + C) * 2u; voffB[i] = (unsigned)(Rb * K + C) * 2u; }
    const size_t kstep = (size_t)(BK * 2);
    const size_t hstep = (size_t)HALF * K * 2;
    const size_t tstep = 2 * hstep;
    const unsigned ldsw = (unsigned)wid * 1024u;
    const int aoff = lds_byte(wr * 64 + fr, fq * 8), boff = lds_byte(wc * 32 + fr, fq * 8);
#define PG8_SA(b, h) (((b) * 2 + (h)) * HTB)
#define PG8_SB(b, h) ((4 + (b) * 2 + (h)) * HTB)
#define PG8_STAGE(bufoff, gbase, voff) do { _Pragma("unroll") for (int _i = 0; _i < 2; ++_i) \
        __builtin_amdgcn_global_load_lds((const unsigned*)((const char*)(gbase) + (voff)[_i]), (PG8_LAS unsigned*)(lds + (bufoff) + ldsw + _i * 8192), 16, 0, 0); } while (0)
#define PG8_LDA(dst, b, h) do { _Pragma("unroll") for (int m = 0; m < 4; ++m) _Pragma("unroll") for (int k = 0; k < 2; ++k) dst[m][k] = *(const PG8_LAS bf16x8*)(lds + PG8_SA(b, h) + aoff + m * 2048 + k * 1024); } while (0)
#define PG8_LDB(dst, b, h) do { _Pragma("unroll") for (int n = 0; n < 2; ++n) _Pragma("unroll") for (int k = 0; k < 2; ++k) dst[n][k] = *(const PG8_LAS bf16x8*)(lds + PG8_SB(b, h) + boff + n * 2048 + k * 1024); } while (0)
#define PG8_MMA(ai, bj, At, Bt) do { __builtin_amdgcn_s_setprio(1); _Pragma("unroll") for (int m = 0; m < 4; ++m) _Pragma("unroll") for (int n = 0; n < 2; ++n) _Pragma("unroll") for (int k = 0; k < 2; ++k) \
        acc[ai][bj][m][n] = __builtin_amdgcn_mfma_f32_16x16x32_bf16(Bt[n][k], At[m][k], acc[ai][bj][m][n], 0, 0, 0); __builtin_amdgcn_s_setprio(0); } while (0)
#define PG8_WAIT_V(n) asm volatile("s_waitcnt vmcnt(" #n ")" ::: "memory")
#define PG8_WAIT_L(n) asm volatile("s_waitcnt lgkmcnt(" #n ")" ::: "memory")
#define PG8_BAR __builtin_amdgcn_s_barrier()
#define PG8_SCHED __builtin_amdgcn_sched_barrier(0)
    Unit cur, nxt; int ui = 0;
    if (!S.next(0, cur)) return;
    f32x4 acc[2][2][4][2];
#pragma unroll
    for (int a = 0; a < 2; ++a)
#pragma unroll
        for (int b = 0; b < 2; ++b)
#pragma unroll
            for (int m = 0; m < 4; ++m)
#pragma unroll
                for (int n = 0; n < 2; ++n) acc[a][b][m][n] = (f32x4){0.f, 0.f, 0.f, 0.f};
    bf16x8 At[4][2], B0[2][2], B1[2][2];
    const char* cA = (const char*)g.A + (size_t)cur.pm * tstep; const char* cB = (const char*)g.Bt + (size_t)cur.pn * tstep;
    S.a_ready(cur);
    if constexpr (SP2) {
        PG8_STAGE(PG8_SB(0, 0), cB, voffB); PG8_STAGE(PG8_SB(0, 1), cB + hstep, voffB); PG8_STAGE(PG8_SA(0, 0), cA, voffA); PG8_STAGE(PG8_SA(0, 1), cA + hstep, voffA);
        if (wr == 1) PG8_BAR;
        PG8_WAIT_V(2); PG8_BAR;
        PG8_STAGE(PG8_SB(1, 0), cB + kstep, voffB); PG8_STAGE(PG8_SA(1, 0), cA + kstep, voffA); PG8_STAGE(PG8_SB(1, 1), cB + hstep + kstep, voffB);
        PG8_WAIT_V(6); PG8_BAR;
    } else {
        PG8_STAGE(PG8_SB(0, 0), cB, voffB); PG8_STAGE(PG8_SA(0, 0), cA, voffA); PG8_STAGE(PG8_SB(0, 1), cB + hstep, voffB); PG8_STAGE(PG8_SA(0, 1), cA + hstep, voffA);
        if (wr == 1) PG8_BAR;
        PG8_WAIT_V(4); PG8_BAR;
        PG8_STAGE(PG8_SB(1, 0), cB + kstep, voffB); PG8_STAGE(PG8_SA(1, 0), cA + kstep, voffA); PG8_STAGE(PG8_SB(1, 1), cB + hstep + kstep, voffB);
        PG8_WAIT_V(6); PG8_BAR;
    }
    for (;;) {
        const bool has_next = S.next(ui + 1, nxt);
        const char* nA = has_next ? (const char*)g.A + (size_t)nxt.pm * tstep : cA; const char* nB = has_next ? (const char*)g.Bt + (size_t)nxt.pn * tstep : cB;
        for (int t = 0; t < nt; t += 2) {
            const bool last = (t == nt - 2);
            const char* a1 = cA + (size_t)(t + 1) * kstep;
            const char* a2 = last ? nA : cA + (size_t)(t + 2) * kstep; const char* b2 = last ? nB : cB + (size_t)(t + 2) * kstep;
            const char* a3 = a2 + kstep; const char* b3 = b2 + kstep;
            if (last && has_next) S.a_ready(nxt);
            if constexpr (SP2) {
            PG8_LDB(B0, 0, 0); PG8_LDB(B1, 0, 1); PG8_SCHED; PG8_LDA(At, 0, 0); PG8_STAGE(PG8_SA(1, 1), a1 + hstep, voffA);
            PG8_WAIT_V(8); PG8_WAIT_L(0); PG8_BAR; PG8_MMA(0, 0, At, B0); PG8_MMA(0, 1, At, B1); PG8_BAR; PG8_SCHED;
            PG8_LDA(At, 0, 1); PG8_STAGE(PG8_SB(0, 0), b2, voffB); PG8_STAGE(PG8_SB(0, 1), b2 + hstep, voffB); PG8_STAGE(PG8_SA(0, 0), a2, voffA);
            PG8_WAIT_V(8); PG8_WAIT_L(0); PG8_BAR; PG8_MMA(1, 0, At, B0); PG8_MMA(1, 1, At, B1); PG8_BAR; PG8_SCHED;
            PG8_LDB(B0, 1, 0); PG8_LDB(B1, 1, 1); PG8_SCHED; PG8_LDA(At, 1, 0); PG8_STAGE(PG8_SA(0, 1), a2 + hstep, voffA);
            PG8_WAIT_V(8); PG8_WAIT_L(0); PG8_BAR; PG8_MMA(0, 0, At, B0); PG8_MMA(0, 1, At, B1); PG8_BAR; PG8_SCHED;
            PG8_LDA(At, 1, 1); PG8_STAGE(PG8_SB(1, 0), b3, voffB); PG8_STAGE(PG8_SB(1, 1), b3 + hstep, voffB); PG8_STAGE(PG8_SA(1, 0), a3, voffA);
            PG8_WAIT_V(8); PG8_WAIT_L(0); PG8_BAR; PG8_MMA(1, 0, At, B0); PG8_MMA(1, 1, At, B1); PG8_BAR; PG8_SCHED;
            } else {
            PG8_LDB(B0, 0, 0); PG8_SCHED; PG8_LDA(At, 0, 0); PG8_STAGE(PG8_SA(1, 1), a1 + hstep, voffA);
            PG8_WAIT_L(8); PG8_BAR; PG8_WAIT_L(0); PG8_MMA(0, 0, At, B0); PG8_BAR; PG8_SCHED;
            PG8_LDB(B1, 0, 1); PG8_STAGE(PG8_SB(0, 0), b2, voffB);
            PG8_BAR; PG8_WAIT_L(0); PG8_MMA(0, 1, At, B1); PG8_BAR;
            PG8_LDA(At, 0, 1); PG8_STAGE(PG8_SA(0, 0), a2, voffA);
            PG8_BAR; PG8_WAIT_L(0); PG8_MMA(1, 0, At, B0); PG8_BAR; PG8_SCHED;
            PG8_STAGE(PG8_SB(0, 1), b2 + hstep, voffB);
            PG8_WAIT_V(6); PG8_BAR; PG8_MMA(1, 1, At, B1); PG8_BAR;
            PG8_LDB(B0, 1, 0); PG8_SCHED; PG8_LDA(At, 1, 0); PG8_STAGE(PG8_SA(0, 1), a2 + hstep, voffA);
            PG8_WAIT_L(8); PG8_BAR; PG8_WAIT_L(0); PG8_MMA(0, 0, At, B0); PG8_BAR; PG8_SCHED;
            PG8_LDB(B1, 1, 1); PG8_STAGE(PG8_SB(1, 0), b3, voffB);
            PG8_BAR; PG8_WAIT_L(0); PG8_MMA(0, 1, At, B1); PG8_BAR;
            PG8_LDA(At, 1, 1); PG8_STAGE(PG8_SA(1, 0), a3, voffA);
            PG8_BAR; PG8_WAIT_L(0); PG8_MMA(1, 0, At, B0); PG8_BAR; PG8_SCHED;
            PG8_STAGE(PG8_SB(1, 1), b3 + hstep, voffB);
            PG8_WAIT_V(6); PG8_BAR; PG8_MMA(1, 1, At, B1); PG8_BAR;
            }
        }
        if constexpr (ALIGN_EPI) { if (wr == 0) PG8_BAR; }
        if constexpr (!Epi::AFTER_DRAIN) { E(acc, cur, wr, wc, fr, fq); S.done(cur); }
        if (!has_next) break;
#pragma unroll
        for (int a = 0; a < 2; ++a)
#pragma unroll
            for (int b = 0; b < 2; ++b)
#pragma unroll
                for (int m = 0; m < 4; ++m)
#pragma unroll
                    for (int n = 0; n < 2; ++n) acc[a][b][m][n] = (f32x4){0.f, 0.f, 0.f, 0.f};
        cur = nxt; cA = nA; cB = nB; ++ui;
        if constexpr (ALIGN_EPI) { if (wr == 1) PG8_BAR; }
    }
    PG8_WAIT_V(0);
    if constexpr (!ALIGN_EPI) { if (wr == 0) PG8_BAR; }
    PG8_BAR;
    if constexpr (Epi::AFTER_DRAIN) { E.fused(acc, cur, wr, wc, fr, fq, lds, wid, lane); S.done(cur); }
#undef PG8_SA
#undef PG8_SB
#undef PG8_STAGE
#undef PG8_LDA
#undef PG8_LDB
#undef PG8_MMA
#undef PG8_WAIT_V
#undef PG8_WAIT_L
#undef PG8_BAR
#undef PG8_SCHED
}
}
#ifndef PG8_SP2
#define PG8_SP2 true
#endif
#ifndef PG8_ALIGN
#define PG8_ALIGN true
#endif
constexpr int NWAVES = 8;
#ifndef MK_PER_PHASE
#define MK_PER_PHASE 0
#endif
constexpr int BATCH = 8, SEQ = 2048, D = 1024, FF = 4096, DEPTH = 4;
constexpr int M = BATCH * SEQ;
constexpr int NQKV = 3 * D;
constexpr int MODW = 6 * D;
constexpr float LN_EPS = 1e-5f, SUBLN_EPS = 1e-5f;
constexpr float DN_ALPHA = 1.681792830507429f;
constexpr float QSCALE = 0.18033688011112042f;
constexpr int NPHASE = 2 + 7 * DEPTH;

constexpr size_t MiB = 1u << 20;
constexpr size_t WS_CTL = 0, CTL_ZERO_BYTES = 1 * MiB;
constexpr size_t WS_MOD = 1 * MiB;
constexpr size_t WS_ROPE = 2 * MiB;
constexpr size_t WS_KPART = 2 * MiB + 512 * 1024;
constexpr size_t WS_XCH = 3 * MiB;
constexpr size_t WS_W = 8 * MiB, W_LAYER = 24 * MiB;
constexpr size_t WOFF_IN = 0, WOFF_O = 6 * MiB, WOFF_UP = 8 * MiB, WOFF_DN = 16 * MiB;
constexpr size_t WS_Q = 104 * MiB, WS_K = 136 * MiB, WS_V = 168 * MiB, WS_O = 200 * MiB;
constexpr size_t WS_H = 104 * MiB;
constexpr size_t WS_HM = 232 * MiB;
constexpr size_t WS_END = 264 * MiB;
static_assert(WS_V - WS_K == WS_K - WS_Q && WS_W + DEPTH * W_LAYER <= WS_Q && WS_H + (size_t)M * FF * 2 <= WS_HM && WS_HM + (size_t)M * D * 2 <= WS_END, "d_ws map");
constexpr int CW_TMO = 0, CW_CODE = 1;
constexpr int CW_BAR = 4096;
constexpr int CW_SEAM = 16384, SEAM_BANK = 128 * 64;

constexpr int RING_OFF = 0, RING_BYTES = 131072;
constexpr int LDSCTL_OFF = RING_BYTES, MISC_OFF = LDSCTL_OFF + 320;
constexpr int LDS_BYTES = 147456;
static_assert(MISC_OFF + 128 <= LDS_BYTES, "LDS map");

#define GAS __attribute__((address_space(1)))
#define LAS __attribute__((address_space(3)))
typedef unsigned short bf16;
typedef unsigned v4u __attribute__((ext_vector_type(4)));
typedef float f32x4 __attribute__((ext_vector_type(4)));
typedef short bf16x8 __attribute__((ext_vector_type(8)));
typedef GAS unsigned gu32;
typedef GAS unsigned long long gu64;
#define RLX_AGENT __ATOMIC_RELAXED, __HIP_MEMORY_SCOPE_AGENT
#define LDS_WAIT() asm volatile("s_waitcnt lgkmcnt(0)" ::: "memory")
#define VM_WAIT() asm volatile("s_waitcnt vmcnt(0)" ::: "memory")
__device__ __forceinline__ unsigned long long rt() { return __builtin_amdgcn_s_memrealtime(); }
__device__ __forceinline__ unsigned f2bf(float f) { unsigned u = __builtin_bit_cast(unsigned, f); return (u + 0x7fffu + ((u >> 16) & 1u)) >> 16; }
__device__ __forceinline__ unsigned pk2(float lo, float hi) { return f2bf(lo) | (f2bf(hi) << 16); }

#define XB_TMO      128
#define XB_XCNT(j)  (256  + 64 * (j))
#define XB_XSUB(j)  (1280 + 64 * (j))
#define XB_XGEN(j)  (2304 + 64 * (j))
#define XB_TOP      3328
#define XB_TOPGEN   3392
#define XCD_BAR_WORDS 3456
#define XB_SPIN_CAP (1u << 23)

__device__ __forceinline__ unsigned xb_ld(unsigned* p)              { return __hip_atomic_load(p, __ATOMIC_RELAXED, __HIP_MEMORY_SCOPE_AGENT); }
__device__ __forceinline__ unsigned xb_add(unsigned* p, unsigned v) { return __hip_atomic_fetch_add(p, v, __ATOMIC_RELAXED, __HIP_MEMORY_SCOPE_AGENT); }
__device__ __forceinline__ unsigned xb_xcc_id() { return (unsigned)__builtin_amdgcn_s_getreg((3 << 11) | 20) & 0xFu; }
#define XB_SPIN(cond, bar) do { unsigned _sp = 0; while (cond) { __builtin_amdgcn_s_sleep(1); \
    if ((++_sp & 255u) == 0u) { if (xb_ld(&(bar)[XB_TMO])) break; if (_sp > XB_SPIN_CAP) { atomicAdd(&(bar)[XB_TMO], 1u); break; } } } } while (0)

struct XcdBarrier {
    unsigned* bar; unsigned x;
    volatile LAS unsigned* st;
};

__device__ __forceinline__ XcdBarrier xcd_barrier_post(unsigned* bar, volatile LAS unsigned* st) {
    XcdBarrier b; b.bar = bar; b.x = xb_xcc_id(); b.st = st;
    if (threadIdx.x == 0) (void)xb_add(&bar[XB_XCNT(b.x)], 1u);
    return b;
}
__device__ __forceinline__ void xcd_barrier_complete(unsigned* bar, unsigned x, unsigned& nloc, unsigned& nx) {
    const unsigned G = gridDim.x * gridDim.y * gridDim.z;
    unsigned sum, cnt, mine, sp = 0u;
    for (;;) {
        sum = 0u; cnt = 0u; mine = 0u;
#pragma unroll
        for (unsigned j = 0; j < 16; ++j) { const unsigned c = xb_ld(&bar[XB_XCNT(j)]); sum += c; cnt += (c > 0u) ? 1u : 0u; mine = (j == x) ? c : mine; }
        if (sum == G) break;
        __builtin_amdgcn_s_sleep(1);
        if ((++sp & 255u) == 0u) { if (xb_ld(&bar[XB_TMO])) break; if (sp > XB_SPIN_CAP) { atomicAdd(&bar[XB_TMO], 1u); break; } }
    }
    nloc = mine > 0u ? mine : 1u; nx = cnt > 0u ? cnt : 1u;
}

__device__ __forceinline__ void xcd_barrier(const XcdBarrier& b) {
    asm volatile("s_waitcnt vmcnt(0)" ::: "memory");
    __syncthreads();
    if (threadIdx.x == 0) {
        unsigned* bar = b.bar;
        __builtin_amdgcn_s_waitcnt(0);
        unsigned nloc = b.st[0], nx = b.st[1];
        if (nloc == 0u) { xcd_barrier_complete(bar, b.x, nloc, nx); b.st[0] = nloc; b.st[1] = nx; }
        const unsigned old = xb_add(&bar[XB_XSUB(b.x)], 1u);
        const unsigned gen = old / nloc;
        if (old + 1u == (gen + 1u) * nloc) {
            __builtin_amdgcn_fence(__ATOMIC_RELEASE, "agent");
            asm volatile("s_waitcnt vmcnt(0)" ::: "memory");
            const unsigned og = xb_add(&bar[XB_TOP], 1u);
            const unsigned tg = og / nx;
            if (og + 1u == (tg + 1u) * nx) xb_add(&bar[XB_TOPGEN], 1u);
            else XB_SPIN(xb_ld(&bar[XB_TOPGEN]) == tg, bar);
            __builtin_amdgcn_fence(__ATOMIC_ACQUIRE, "agent");
            xb_add(&bar[XB_XGEN(b.x)], 1u);
            asm volatile("s_waitcnt vmcnt(0)" ::: "memory");
        } else {
            XB_SPIN(xb_ld(&bar[XB_XGEN(b.x)]) == gen, bar);
            __builtin_amdgcn_fence(__ATOMIC_ACQUIRE, "agent");
            asm volatile("s_waitcnt vmcnt(0)" ::: "memory");
        }
    }
    __syncthreads();
}

struct Args { const float* in[17]; float* out; unsigned char* ws; int ph_lo, ph_hi; };
struct Frame {
    LAS unsigned char* lds;
    volatile LAS unsigned* MISC;
    gu32* ctl;
    int tid, lane, wave;
    int vcu, G;
    const struct Args* a;
    unsigned char* ws;
    int z;
};
#define F_X (F.a->in[0 + F.z])
#define F_C (F.a->in[1 + F.z])
#define F_MOBA_W_IN (F.a->in[2 + F.z])
#define F_MOBA_W_OUT (F.a->in[3 + F.z])
#define F_DIFF_W_IN (F.a->in[4 + F.z])
#define F_DIFF_W_OUT (F.a->in[5 + F.z])
#define F_LAM_Q1 (F.a->in[6 + F.z])
#define F_LAM_K1 (F.a->in[7 + F.z])
#define F_LAM_Q2 (F.a->in[8 + F.z])
#define F_LAM_K2 (F.a->in[9 + F.z])
#define F_SUBLN_G (F.a->in[10 + F.z])
#define F_ADA_W (F.a->in[11 + F.z])
#define F_ADA_B (F.a->in[12 + F.z])
#define F_LN_G (F.a->in[13 + F.z])
#define F_LN_B (F.a->in[14 + F.z])
#define F_W_UP (F.a->in[15 + F.z])
#define F_W_DOWN (F.a->in[16 + F.z])
#define F_OUT ((&F.a->out)[F.z])
#define F_MOD ((float*)(F.ws + WS_MOD))
#define F_ROPE ((float*)(F.ws + WS_ROPE))
#define F_KPART ((float*)(F.ws + WS_KPART))
#define F_Q ((bf16*)(F.ws + WS_Q))
#define F_K ((bf16*)(F.ws + WS_K))
#define F_V ((bf16*)(F.ws + WS_V))
#define F_O ((bf16*)(F.ws + WS_O))
#define F_H ((bf16*)(F.ws + WS_H))
#define F_HM ((bf16*)(F.ws + WS_HM))
__device__ __forceinline__ bf16* w_in_t(Frame& F, int l) { return (bf16*)(F.ws + WS_W + (size_t)l * W_LAYER + WOFF_IN); }
__device__ __forceinline__ bf16* w_o_t(Frame& F, int l)  { return (bf16*)(F.ws + WS_W + (size_t)l * W_LAYER + WOFF_O); }
__device__ __forceinline__ bf16* w_up_t(Frame& F, int l) { return (bf16*)(F.ws + WS_W + (size_t)l * W_LAYER + WOFF_UP); }
__device__ __forceinline__ bf16* w_dn_t(Frame& F, int l) { return (bf16*)(F.ws + WS_W + (size_t)l * W_LAYER + WOFF_DN); }

__device__ __forceinline__ float wave_sum(float v) {
#pragma unroll
    for (int o = 1; o < 64; o <<= 1) v += __shfl_xor(v, o);
    return v;
}
__device__ __forceinline__ float wave_max(float v) {
#pragma unroll
    for (int o = 1; o < 64; o <<= 1) v = fmaxf(v, __shfl_xor(v, o));
    return v;
}
__device__ __forceinline__ float bf2f(bf16 h) { return __builtin_bit_cast(float, (unsigned)h << 16); }
__device__ __forceinline__ void p0_transpose_item(const float* W, int K, int N, bf16* WT, int row_off, LAS float* scr, int item, int lane) {
    const int nblk = N / 32, kb = item / nblk, nb = item % nblk, k0 = 64 * kb, n0 = 32 * nb;
#pragma unroll 8
    for (int i = 0; i < 32; ++i) { const int kk = 2 * i + (lane >> 5); scr[kk * 33 + (lane & 31)] = W[(size_t)(k0 + kk) * N + n0 + (lane & 31)]; }
    LDS_WAIT(); asm volatile("" ::: "memory");
    const int c = lane & 7;
#pragma unroll
    for (int j = 0; j < 4; ++j) { const int n = (lane >> 3) + 8 * j; const LAS float* s = scr + (8 * c) * 33 + n;
        v4u o; o.x = pk2(s[0 * 33], s[1 * 33]); o.y = pk2(s[2 * 33], s[3 * 33]); o.z = pk2(s[4 * 33], s[5 * 33]); o.w = pk2(s[6 * 33], s[7 * 33]);
        *(GAS v4u*)(WT + (size_t)(row_off + n0 + n) * K + k0 + 8 * c) = o; }
    LDS_WAIT(); asm volatile("" ::: "memory");
}
__device__ __forceinline__ void sincos_d(double a, double& s, double& c) {
    const double kq = rint(a * 0.63661977236758134308);
    double r = fma(-kq, 1.57079632679489655800, a); r = fma(-kq, 6.12323399573676603587e-17, r);
    const double r2 = r * r;
    double sp = -1.0 / 1307674368000.0; sp = fma(sp, r2, 1.0 / 6227020800.0); sp = fma(sp, r2, -1.0 / 39916800.0); sp = fma(sp, r2, 1.0 / 362880.0); sp = fma(sp, r2, -1.0 / 5040.0); sp = fma(sp, r2, 1.0 / 120.0); sp = fma(sp, r2, -1.0 / 6.0); sp = fma(sp, r2, 1.0);
    const double sr = r * sp;
    double cp = 1.0 / 20922789888000.0; cp = fma(cp, r2, -1.0 / 87178291200.0); cp = fma(cp, r2, 1.0 / 479001600.0); cp = fma(cp, r2, -1.0 / 3628800.0); cp = fma(cp, r2, 1.0 / 40320.0); cp = fma(cp, r2, -1.0 / 720.0); cp = fma(cp, r2, 1.0 / 24.0); cp = fma(cp, r2, -0.5); cp = fma(cp, r2, 1.0);
    const int q = (int)kq & 3;
    s = (q == 0) ? sr : (q == 1) ? cp : (q == 2) ? -sr : -cp;
    c = (q == 0) ? cp : (q == 1) ? -sr : (q == 2) ? -cp : sr;
}
__device__ __forceinline__ float rope_inv(int j) {
    return j == 0 ? 1.0f : j == 1 ? 0.19392274474868576f : j == 2 ? 0.03760603093086393f : j == 3 ? 0.007292664737217109f : j == 4 ? 0.001414213562373095f
         : j == 5 ? 0.0002742481756762073f : j == 6 ? 5.318295896944988e-05f : 1.031338537721246e-05f;
}
__device__ __forceinline__ void p0_prologue(Frame& F) {
    LAS float* scr = (LAS float*)(F.lds + RING_OFF + F.wave * 16384);
    const int gw = F.vcu * NWAVES + F.wave, NGW = F.G * NWAVES;
    constexpr int I_IN = (D / 64) * (NQKV / 32), I_O = (D / 64) * (D / 32), I_UP = (D / 64) * (FF / 32), I_DN = (FF / 64) * (D / 32), PER = I_IN + I_O + I_UP + I_DN;
    for (int it = gw; it < DEPTH * PER; it += NGW) {
        const int l = it / PER, j = l >> 1; int r = it % PER;
        if (r < I_IN) { const float* src = ((l & 1) ? F_DIFF_W_IN : F_MOBA_W_IN) + (size_t)j * D * NQKV; p0_transpose_item(src, D, NQKV, w_in_t(F, l), 0, scr, r, F.lane); continue; } r -= I_IN;
        if (r < I_O)  { const float* src = ((l & 1) ? F_DIFF_W_OUT : F_MOBA_W_OUT) + (size_t)j * D * D; p0_transpose_item(src, D, D, w_o_t(F, l), 0, scr, r, F.lane); continue; } r -= I_O;
        if (r < I_UP) { p0_transpose_item(F_W_UP + (size_t)l * D * FF, D, FF, w_up_t(F, l), 0, scr, r, F.lane); continue; } r -= I_UP;
        p0_transpose_item(F_W_DOWN + (size_t)l * FF * D, FF, D, w_dn_t(F, l), 0, scr, r, F.lane);
    }
    for (int e = F.vcu * (NWAVES * 64) + F.tid; e < SEQ * 8; e += F.G * NWAVES * 64) {
        const int pos = e >> 3, j = e & 7; const float ang = (float)pos * rope_inv(j);
        double s, c; sincos_d((double)ang, s, c);
        F_ROPE[pos * 16 + j] = (float)c; F_ROPE[pos * 16 + 8 + j] = (float)s;
    }
    __syncthreads();
    LAS float* sl = (LAS float*)(F.lds + RING_OFF);
    LAS float* red = (LAS float*)(F.lds + RING_OFF + 32768);
    for (int i = F.tid; i < BATCH * D; i += NWAVES * 64) { const float cv = F_C[i]; sl[i] = cv / (1.0f + expf(-cv)); }
    __syncthreads();
    for (int it = F.vcu; it < DEPTH * (MODW / 64); it += F.G) {
        const int l = it / (MODW / 64), ch = it % (MODW / 64);
        const float* w = F_ADA_W + (size_t)l * D * MODW + (size_t)(F.wave * 128) * MODW + ch * 64 + F.lane;
        float a[8];
#pragma unroll
        for (int b = 0; b < 8; ++b) a[b] = 0.f;
#pragma unroll 8
        for (int d = 0; d < 128; ++d) { const float wv = w[(size_t)d * MODW];
#pragma unroll
            for (int b = 0; b < 8; ++b) a[b] += sl[b * D + F.wave * 128 + d] * wv; }
#pragma unroll
        for (int b = 0; b < 8; ++b) red[(F.wave * 8 + b) * 64 + F.lane] = a[b];
        __syncthreads();
        { const int b = F.tid >> 6, cl = F.tid & 63; float s = F_ADA_B[l * MODW + ch * 64 + cl];
#pragma unroll
          for (int w8 = 0; w8 < 8; ++w8) s += red[(w8 * 8 + b) * 64 + cl];
          F_MOD[(size_t)(l * BATCH + b) * MODW + ch * 64 + cl] = s; }
        __syncthreads();
    }
}
__device__ __forceinline__ void p1_hm0(Frame& F) {
    const int gw = F.vcu * NWAVES + F.wave, NGW = F.G * NWAVES;
    for (int m = gw; m < M; m += NGW) {
        const int b = m >> 11; const float* md = F_MOD + (size_t)b * MODW;
        const GAS f32x4* xr = (const GAS f32x4*)(F_X + (size_t)m * D) + F.lane;
        GAS unsigned long long* o8 = (GAS unsigned long long*)(F_HM + (size_t)m * D) + F.lane;
#pragma unroll
        for (int j = 0; j < 4; ++j) { const f32x4 v = xr[64 * j]; const int col = 4 * F.lane + 256 * j;
            const f32x4 sh = *(const f32x4*)(md + col), sc = *(const f32x4*)(md + 1024 + col);
            const f32x4 h = v * (sc + 1.0f) + sh;
            o8[64 * j] = (unsigned long long)pk2(h.x, h.y) | ((unsigned long long)pk2(h.z, h.w) << 32); }
    }
}
__device__ __forceinline__ void ln_rows_phase(Frame& F, float* x, const float* g, const float* bt, const float* shift, const float* scale, bf16* hm) {
    const int gw = F.vcu * NWAVES + F.wave, NGW = F.G * NWAVES;
    for (int m = gw; m < M; m += NGW) {
        const int b = m >> 11;
        GAS f32x4* xr = (GAS f32x4*)(x + (size_t)m * D) + F.lane;
        f32x4 v[4]; float s = 0.f;
#pragma unroll
        for (int j = 0; j < 4; ++j) { v[j] = xr[64 * j]; s += (v[j].x + v[j].y) + (v[j].z + v[j].w); }
        const float mean = wave_sum(s) * (1.f / D); float s2 = 0.f;
#pragma unroll
        for (int j = 0; j < 4; ++j) { v[j] = v[j] - mean; s2 += (v[j].x * v[j].x + v[j].y * v[j].y) + (v[j].z * v[j].z + v[j].w * v[j].w); }
        const float rstd = 1.f / sqrtf(wave_sum(s2) * (1.f / D) + LN_EPS);
        GAS unsigned long long* o8 = (GAS unsigned long long*)(hm + (size_t)m * D) + F.lane;
#pragma unroll
        for (int j = 0; j < 4; ++j) { const int col = 4 * F.lane + 256 * j;
            const f32x4 xn = (v[j] * rstd) * *(const f32x4*)(g + col) + *(const f32x4*)(bt + col);
            xr[64 * j] = xn;
            if (hm) { const f32x4 h = xn * (*(const f32x4*)(scale + (size_t)b * MODW + col) + 1.0f) + *(const f32x4*)(shift + (size_t)b * MODW + col);
                o8[64 * j] = (unsigned long long)pk2(h.x, h.y) | ((unsigned long long)pk2(h.z, h.w) << 32); } }
    }
}
template <int DV>
__device__ __forceinline__ void naive_attend(const bf16* qrow, const bf16* Kb, const bf16* Vb, const int (&rs)[4], const int (&rc)[4], int nr, LAS float* sc, int lane, float& o0, float& o1) {
    unsigned qp[32];
#pragma unroll
    for (int i = 0; i < 8; ++i) { const v4u t = *(const v4u*)(qrow + 8 * i); qp[4 * i] = t.x; qp[4 * i + 1] = t.y; qp[4 * i + 2] = t.z; qp[4 * i + 3] = t.w; }
    float mx = -INFINITY; int off = 0;
#pragma unroll
    for (int r = 0; r < 4; ++r) if (r < nr) {
        for (int i = lane; i < rc[r]; i += 64) {
            const v4u* kp = (const v4u*)(Kb + (size_t)(rs[r] + i) * 1024);
            float dot = 0.f;
#pragma unroll
            for (int c8 = 0; c8 < 8; ++c8) { const v4u kk = kp[c8];
#pragma unroll
                for (int e = 0; e < 4; ++e) dot += __builtin_bit_cast(float, kk[e] << 16) * __builtin_bit_cast(float, qp[c8 * 4 + e] << 16) + __builtin_bit_cast(float, kk[e] & 0xffff0000u) * __builtin_bit_cast(float, qp[c8 * 4 + e] & 0xffff0000u); }
            sc[off + i] = dot; mx = fmaxf(mx, dot);
        }
        off += rc[r];
    }
    mx = wave_max(mx);
    LDS_WAIT();
    float sum = 0.f; o0 = 0.f; o1 = 0.f; off = 0;
#pragma unroll
    for (int r = 0; r < 4; ++r) if (r < nr) {
        const bf16* vp = Vb + (size_t)rs[r] * 1024 + lane;
#pragma unroll 4
        for (int i = 0; i < rc[r]; ++i) { const float p = __builtin_amdgcn_exp2f(sc[off + i] - mx); sum += p; o0 += p * bf2f(vp[(size_t)i * 1024]); if (DV == 128) o1 += p * bf2f(vp[(size_t)i * 1024 + 64]); }
        off += rc[r];
    }
    const float inv = 1.0f / sum; o0 *= inv; o1 *= inv;
    LDS_WAIT();
}
__device__ __forceinline__ void moba_naive_phase(Frame& F) {
    const int gw = F.vcu * NWAVES + F.wave, NGW = F.G * NWAVES; const int lane = F.lane;
    LAS float* sc = (LAS float*)(F.lds + RING_OFF) + F.wave * 2048;
    for (int it = gw; it < BATCH * 16 * SEQ; it += NGW) {
        const int bh = it & 127, s = it >> 7, b = bh >> 4, h = bh & 15, jq = s >> 8;
        const size_t rowb = (size_t)b * SEQ;
        const bf16* qrow = F_Q + (rowb + s) * 1024 + h * 64;
        const float qd = bf2f(qrow[lane]);
        float g[8];
#pragma unroll
        for (int n = 0; n < 8; ++n) { g[n] = -INFINITY;
            if (n < jq) { const float* kp = F_KPART + (size_t)((b * 8 + n) * 2) * 1024 + h * 64 + lane; g[n] = wave_sum(qd * (kp[0] + kp[1024])); } }
        unsigned picked = 0u; int selblk[3];
#pragma unroll
        for (int t = 0; t < 3; ++t) { float best = -INFINITY; int bi = -1;
#pragma unroll
            for (int n = 0; n < 8; ++n) { const bool ok = (n < jq) && !((picked >> n) & 1u) && (bi < 0 || g[n] > best); if (ok) { best = g[n]; bi = n; } }
            selblk[t] = bi; if (bi >= 0) picked |= 1u << bi; }
        int rs[4], rc[4];
        rs[0] = jq * 256; rc[0] = s - jq * 256 + 1;
#pragma unroll
        for (int t = 0; t < 3; ++t) { rs[t + 1] = selblk[t] * 256; rc[t + 1] = 256; }
        const int nr = 1 + (jq < 3 ? jq : 3);
        float o0, o1;
        naive_attend<64>(qrow, F_K + rowb * 1024 + h * 64, F_V + rowb * 1024 + h * 64, rs, rc, nr, sc, lane, o0, o1);
        F_O[(rowb + s) * 1024 + h * 64 + lane] = (bf16)f2bf(o0);
    }
}
__device__ __forceinline__ void diff_naive_phase(Frame& F, int j, float lambda_init) {
    const int gw = F.vcu * NWAVES + F.wave, NGW = F.G * NWAVES; const int lane = F.lane;
    LAS float* sc = (LAS float*)(F.lds + RING_OFF) + F.wave * 2048;
    const float lam = expf(wave_sum(F_LAM_Q1[j * 64 + lane] * F_LAM_K1[j * 64 + lane])) - expf(wave_sum(F_LAM_Q2[j * 64 + lane] * F_LAM_K2[j * 64 + lane])) + lambda_init;
    const float g0 = F_SUBLN_G[j * 128 + lane] * (1.0f - lambda_init), g1 = F_SUBLN_G[j * 128 + 64 + lane] * (1.0f - lambda_init);
    for (int it = gw; it < BATCH * 8 * SEQ; it += NGW) {
        const int bh = it & 63, s = it >> 6, b = bh >> 3, h = bh & 7;
        const size_t rowb = (size_t)b * SEQ;
        int rs[4], rc[4]; rs[0] = 0; rc[0] = s + 1; rs[1] = rs[2] = rs[3] = 0; rc[1] = rc[2] = rc[3] = 0;
        float a0, a1, b0, b1;
        naive_attend<128>(F_Q + (rowb + s) * 1024 + h * 128, F_K + rowb * 1024 + h * 128, F_V + rowb * 1024 + h * 128, rs, rc, 1, sc, lane, a0, a1);
        naive_attend<128>(F_Q + (rowb + s) * 1024 + h * 128 + 64, F_K + rowb * 1024 + h * 128 + 64, F_V + rowb * 1024 + h * 128, rs, rc, 1, sc, lane, b0, b1);
        const float o0 = a0 - lam * b0, o1 = a1 - lam * b1;
        const float r = 1.0f / sqrtf(wave_sum(o0 * o0 + o1 * o1) * (1.0f / 128.0f) + SUBLN_EPS);
        F_O[(rowb + s) * 1024 + h * 128 + lane] = (bf16)f2bf(o0 * r * g0);
        F_O[(rowb + s) * 1024 + h * 128 + 64 + lane] = (bf16)f2bf(o1 * r * g1);
    }
}

__global__ void __launch_bounds__(NWAVES * 64, 2) mk_fwd(Args args) {
    extern __shared__ __attribute__((aligned(16))) unsigned char lds[];
    Frame F;
    F.lds = (LAS unsigned char*)lds;
    F.MISC = (volatile LAS unsigned*)(F.lds + MISC_OFF);
    F.tid = threadIdx.x; F.lane = F.tid & 63; F.wave = __builtin_amdgcn_readfirstlane(F.tid >> 6);
    F.G = gridDim.x; { const int bx = blockIdx.x; F.vcu = (F.G % 8 == 0) ? (bx % 8) * (F.G / 8) + bx / 8 : bx; }
    unsigned char* ws = args.ws; F.ws = ws;
    F.ctl = (gu32*)(ws + WS_CTL);
    F.a = &args;
    for (int u = F.tid; u < (LDS_BYTES - LDSCTL_OFF) / 4; u += NWAVES * 64) ((LAS unsigned*)(F.lds + LDSCTL_OFF))[u] = 0u;
    __syncthreads();
    const int lo = args.ph_lo, hi = args.ph_hi;
    XcdBarrier bar; bar.bar = (unsigned*)(F.ctl + CW_BAR); bar.x = 0; bar.st = nullptr;
    if (hi - lo > 1) bar = xcd_barrier_post((unsigned*)(F.ctl + CW_BAR), F.MISC + 8);
    for (int ph = lo; ph < hi; ++ph) {
        { int t = threadIdx.x; asm volatile("" : "+v"(t)); F.tid = t; F.lane = t & 63; F.wave = __builtin_amdgcn_readfirstlane(t >> 6); }
        { unsigned char* w_ = args.ws; asm volatile("" : "+s"(w_)); F.ws = w_; int z_ = 0; asm volatile("" : "+s"(z_)); F.z = z_; }
        if (ph == 0) p0_prologue(F);
        else if (ph == 1) p1_hm0(F);
        else {
            const int l = (ph - 2) / 7, kind = (ph - 2) % 7; const int jm = l >> 1; const bool is_diff = (l & 1) != 0;
            const float* modl = F_MOD + (size_t)l * BATCH * MODW;
            if (kind == 0) {
                pg8::Gemm g{F_HM, w_in_t(F, l), M, NQKV, D}; pg8::StaticOrder S; S.init(M, NQKV, F.G, (int)blockIdx.x);
                pg8::EpiQKV E{F_Q, (size_t)(WS_K - WS_Q) / 2, F_ROPE, is_diff ? nullptr : F_KPART, QSCALE};
                pg8::gemm_phase<pg8::EpiQKV, pg8::StaticOrder, PG8_ALIGN, PG8_SP2>(F.lds + RING_OFF, g, S, E);
            } else if (kind == 1) {
                if (is_diff) diff_naive_phase(F, jm, l == 1 ? 0.35550906759096934f : 0.5560582041556406f);
                else moba_naive_phase(F);
            } else if (kind == 2) {
                pg8::Gemm g{F_O, w_o_t(F, l), M, D, D}; pg8::StaticOrder S; S.init(M, D, F.G, (int)blockIdx.x);
                pg8::EpiResid E{l == 0 ? F_X : (const float*)F_OUT, F_OUT, modl + 2048, DN_ALPHA};
                pg8::gemm_phase<pg8::EpiResid, pg8::StaticOrder, PG8_ALIGN, PG8_SP2>(F.lds + RING_OFF, g, S, E);
            } else if (kind == 3) {
                ln_rows_phase(F, F_OUT, F_LN_G + (size_t)(l * 2 + 0) * D, F_LN_B + (size_t)(l * 2 + 0) * D, modl + 3072, modl + 4096, F_HM);
            } else if (kind == 4) {
                pg8::Gemm g{F_HM, w_up_t(F, l), M, FF, D}; pg8::StaticOrder S; S.init(M, FF, F.G, (int)blockIdx.x);
                pg8::EpiSqRelu E{F_H, FF};
                pg8::gemm_phase<pg8::EpiSqRelu, pg8::StaticOrder, PG8_ALIGN, PG8_SP2>(F.lds + RING_OFF, g, S, E);
            } else if (kind == 5) {
                pg8::Gemm g{F_H, w_dn_t(F, l), M, D, FF}; pg8::StaticOrder S; S.init(M, D, F.G, (int)blockIdx.x);
                pg8::EpiResid E{F_OUT, F_OUT, modl + 5120, DN_ALPHA};
                pg8::gemm_phase<pg8::EpiResid, pg8::StaticOrder, PG8_ALIGN, PG8_SP2>(F.lds + RING_OFF, g, S, E);
            } else {
                const float* modn = modl + (size_t)BATCH * MODW;
                ln_rows_phase(F, F_OUT, F_LN_G + (size_t)(l * 2 + 1) * D, F_LN_B + (size_t)(l * 2 + 1) * D, modn + 0, modn + 1024, (l + 1 < DEPTH) ? F_HM : (bf16*)nullptr);
            }
        }
        if (ph + 1 < hi) xcd_barrier(bar);
    }
}

extern "C" void kernel_launch(void* const* d_in, const int* in_sizes, int n_in, void* d_out, int out_size, void* d_ws, size_t ws_size, hipStream_t stream) {
    static int grid = 0;
    if (grid == 0) {
        if (n_in != 17 || in_sizes[0] != M * D || out_size != M * D || ws_size < WS_END) { fprintf(stderr, "kernel_launch: built for 17 inputs, x and out of %d floats, >= %zu bytes of workspace; got n_in %d, in0 %d, out %d, ws %zu; nothing launched\n", M * D, (size_t)WS_END, n_in, n_in > 0 ? in_sizes[0] : -1, out_size, ws_size); grid = -1; return; }
        int dev = 0, cus = 0, per_cu = 0;
        if (hipGetDevice(&dev) != hipSuccess || hipDeviceGetAttribute(&cus, hipDeviceAttributeMultiprocessorCount, dev) != hipSuccess) { fprintf(stderr, "kernel_launch: hipGetDevice / hipDeviceGetAttribute failed; nothing launched\n"); grid = -1; return; }
        if (hipFuncSetAttribute((const void*)mk_fwd, hipFuncAttributeMaxDynamicSharedMemorySize, LDS_BYTES) != hipSuccess) { fprintf(stderr, "kernel_launch: hipFuncSetAttribute failed\n"); grid = -1; return; }
        if (hipOccupancyMaxActiveBlocksPerMultiprocessor(&per_cu, (const void*)mk_fwd, NWAVES * 64, LDS_BYTES) != hipSuccess || per_cu < 1)
            fprintf(stderr, "kernel_launch: note: the occupancy query reports %d workgroups per CU\n", per_cu);
        (void)hipGetLastError();
        grid = cus;
        if (grid != 256) fprintf(stderr, "kernel_launch: launching %d workgroups (built for 256 CUs)\n", grid);
    }
    if (grid < 0) return;
    if (hipMemsetAsync((char*)d_ws + WS_CTL, 0, CTL_ZERO_BYTES, stream) != hipSuccess) { fprintf(stderr, "kernel_launch: hipMemsetAsync of the control words failed; nothing launched\n"); return; }
    Args a{};
    for (int i = 0; i < 17; ++i) a.in[i] = (const float*)d_in[i];
    a.out = (float*)d_out; a.ws = (unsigned char*)d_ws;
#if MK_PER_PHASE
    for (int p = 0; p < NPHASE; ++p) { a.ph_lo = p; a.ph_hi = p + 1; hipLaunchKernelGGL(mk_fwd, dim3(grid), dim3(NWAVES * 64), LDS_BYTES, stream, a); }
#else
    a.ph_lo = 0; a.ph_hi = NPHASE;
    hipLaunchKernelGGL(mk_fwd, dim3(grid), dim3(NWAVES * 64), LDS_BYTES, stream, a);
#endif
    const hipError_t le = hipPeekAtLastError();
    if (le != hipSuccess) fprintf(stderr, "kernel_launch: launch failed: %s (grid %d x %d threads, %d B LDS)\n", hipGetErrorName(le), grid, NWAVES * 64, LDS_BYTES);
}
```

```cpp
#include <hip/hip_runtime.h>
#include <cstdio>
#include <cstdint>
#include <cmath>
namespace pg8 {
#define PG8_LAS __attribute__((address_space(3)))
typedef unsigned short bf16_t;
typedef short bf16x8 __attribute__((ext_vector_type(8)));
typedef float f32x4 __attribute__((ext_vector_type(4)));
typedef unsigned u32x4 __attribute__((ext_vector_type(4)));
constexpr int BM = 256, BK = 64, HALF = 128, HTB = HALF * BK * 2  , STAGE_BYTES = 8 * HTB, NXCD = 8, WGM = 8;

__host__ __device__ __forceinline__ int lds_byte(int r, int c) { const int st = (r >> 4) * 2 + (c >> 5), rr = r & 15, cc = c & 31, ob = rr * 64 + cc * 2; return st * 1024 + (ob ^ (((ob >> 9) & 1) << 5)); }
__host__ __device__ __forceinline__ void stage_rc(int b, int& R, int& C) { const int st = b / 1024, sb = b % 1024, swz = sb ^ (((sb >> 9) & 1) << 5); R = (st >> 1) * 16 + swz / 64; C = (st & 1) * 32 + (swz % 64) / 2; }
__host__ __device__ __forceinline__ int perm32(int rho) { const int n = rho >> 4, i = rho & 15; return 8 * (i >> 2) + 4 * n + (i & 3); }

struct Unit { int pm, pn; };
struct Gemm { const bf16_t* A; const bf16_t* Bt; int M, N, K; };

struct StaticOrder {
    int nM, nN, nwg, G, c;
    __host__ __device__ void init(int M, int N, int G_, int c_) { nM = M / BM; nN = N / BM; nwg = nM * nN; G = G_; c = c_; }
    __host__ __device__ bool next(int i, Unit& u) const {
        const long L = (long)i * G + c; if (L >= nwg) return false;
        int wgid = (int)L; { const int q = nwg / NXCD, r = nwg % NXCD, xcd = wgid % NXCD, off = wgid / NXCD; wgid = (xcd < r ? xcd * (q + 1) : r * (q + 1) + (xcd - r) * q) + off; }
        const int nig = WGM * nN, gid = wgid / nig, fm = gid * WGM, gsz = (nM - fm) < WGM ? (nM - fm) : WGM;
        u.pm = fm + ((wgid % nig) % gsz); u.pn = (wgid % nig) / gsz; return true;
    }
    __device__ __forceinline__ void a_ready(const Unit&) const {}
    __device__ __forceinline__ void done(const Unit&) const {}
};

__device__ __forceinline__ unsigned cvt_pk_bf16(float lo, float hi) { unsigned r; asm volatile("v_cvt_pk_bf16_f32 %0, %1, %2" : "=v"(r) : "v"(lo), "v"(hi)); return r; }
typedef float f32x2 __attribute__((ext_vector_type(2)));
struct EpiQKV {
    static constexpr bool PERM = true, AFTER_DRAIN = false;
    bf16_t* Q; size_t tstride;
    const float* rope;
    float* kpart;
    float qscale;
    __device__ __forceinline__ void operator()(const f32x4 (&acc)[2][2][4][2], const Unit& u, int wr, int wc, int fr, int fq) const {
        asm volatile("" : "+v"(fr), "+v"(fq));
        const int t = u.pn >> 2;
        bf16_t* base = Q + (size_t)t * tstride;
        const int colt = (u.pn & 3) * BM;
        const int col0 = colt + wc * 32 + 8 * fq;
        const float sc = (t == 0) ? qscale : 1.f;
        const bool do_rope = (t < 2) && ((wc & 1) == 0);
        const bool do_ksum = (t == 1) && (kpart != nullptr);
        const float sg = (fq == 0) ? -1.f : 1.f;
        float ks[2][8];
#pragma unroll
        for (int bj = 0; bj < 2; ++bj)
#pragma unroll
            for (int e = 0; e < 8; ++e) ks[bj][e] = 0.f;
#pragma unroll
        for (int ai = 0; ai < 2; ++ai)
#pragma unroll
            for (int m = 0; m < 4; ++m) {
                const int row = u.pm * BM + ai * HALF + wr * 64 + m * 16 + fr;
                const int pos = row & 2047;
                bf16_t* rowp = base + (size_t)row * 1024 + col0;
                f32x4 c0 = {1.f, 1.f, 1.f, 1.f}, c1 = c0, s0 = {0.f, 0.f, 0.f, 0.f}, s1 = s0;
                if (do_rope && fq < 2) { const float* cs = rope + pos * 16; c0 = *(const f32x4*)(cs); c1 = *(const f32x4*)(cs + 4); s0 = *(const f32x4*)(cs + 8); s1 = *(const f32x4*)(cs + 12); }
#pragma unroll
                for (int bj = 0; bj < 2; ++bj) {
                    f32x4 v0 = acc[ai][bj][m][0], v1 = acc[ai][bj][m][1];
                    if (do_rope) {
                        f32x4 p0, p1;
#pragma unroll
                        for (int e = 0; e < 4; ++e) { p0[e] = __shfl_xor(v0[e], 16); p1[e] = __shfl_xor(v1[e], 16); }
                        v0 = v0 * c0 + (p0 * s0) * sg; v1 = v1 * c1 + (p1 * s1) * sg;
                    }
                    if (do_ksum) {
#pragma unroll
                        for (int e = 0; e < 4; ++e) { ks[bj][e] += v0[e]; ks[bj][4 + e] += v1[e]; }
                    }
                    v0 = v0 * sc; v1 = v1 * sc;
                    u32x4 w; w.x = cvt_pk_bf16(v0[0], v0[1]); w.y = cvt_pk_bf16(v0[2], v0[3]); w.z = cvt_pk_bf16(v1[0], v1[1]); w.w = cvt_pk_bf16(v1[2], v1[3]);
                    *(u32x4*)(rowp + bj * HALF) = w;
                }
            }
        if (do_ksum) {
#pragma unroll
            for (int bj = 0; bj < 2; ++bj)
#pragma unroll
                for (int e = 0; e < 8; ++e) { float v = ks[bj][e]; v += __shfl_xor(v, 1); v += __shfl_xor(v, 2); v += __shfl_xor(v, 4); v += __shfl_xor(v, 8); ks[bj][e] = v; }
            if (fr == 0) {
                float* kp = kpart + ((size_t)(u.pm * 2 + wr)) * 1024 + col0;
#pragma unroll
                for (int bj = 0; bj < 2; ++bj) { *(f32x4*)(kp + bj * HALF) = (f32x4){ks[bj][0], ks[bj][1], ks[bj][2], ks[bj][3]}; *(f32x4*)(kp + bj * HALF + 4) = (f32x4){ks[bj][4], ks[bj][5], ks[bj][6], ks[bj][7]}; }
            }
        }
    }
};
struct EpiSqRelu {
    static constexpr bool PERM = true, AFTER_DRAIN = false;
    bf16_t* O; int ldc;
    __device__ __forceinline__ void operator()(const f32x4 (&acc)[2][2][4][2], const Unit& u, int wr, int wc, int fr, int fq) const {
        asm volatile("" : "+v"(fr), "+v"(fq));
        const int row0 = u.pm * BM + wr * 64 + fr; const int col0 = u.pn * BM + wc * 32 + 8 * fq;
#pragma unroll
        for (int ai = 0; ai < 2; ++ai)
#pragma unroll
            for (int m = 0; m < 4; ++m) { bf16_t* rowp = O + (size_t)(row0 + ai * HALF + m * 16) * ldc + col0;
#pragma unroll
                for (int bj = 0; bj < 2; ++bj) { f32x4 v0 = acc[ai][bj][m][0], v1 = acc[ai][bj][m][1];
#pragma unroll
                    for (int e = 0; e < 4; ++e) { const float a = fmaxf(v0[e], 0.f), b = fmaxf(v1[e], 0.f); v0[e] = a * a; v1[e] = b * b; }
                    u32x4 w; w.x = cvt_pk_bf16(v0[0], v0[1]); w.y = cvt_pk_bf16(v0[2], v0[3]); w.z = cvt_pk_bf16(v1[0], v1[1]); w.w = cvt_pk_bf16(v1[2], v1[3]);
                    *(u32x4*)(rowp + bj * HALF) = w; } }
    }
};
struct EpiResid {
    static constexpr bool PERM = false, AFTER_DRAIN = false;
    const float* xin; float* out; const float* gate; float alpha;
    __device__ __forceinline__ void operator()(const f32x4 (&acc)[2][2][4][2], const Unit& u, int wr, int wc, int fr, int fq) const {
        asm volatile("" : "+v"(fr), "+v"(fq));
        const int col0 = u.pn * BM + wc * 32 + 4 * fq; const int b = u.pm >> 3;
        f32x4 g[2][2];
#pragma unroll
        for (int bj = 0; bj < 2; ++bj)
#pragma unroll
            for (int n = 0; n < 2; ++n) g[bj][n] = *(const f32x4*)(gate + b * 6144 + col0 + bj * HALF + n * 16) + 1.0f;
#pragma unroll
        for (int ai = 0; ai < 2; ++ai)
#pragma unroll
            for (int m = 0; m < 4; ++m) { const size_t off = (size_t)(u.pm * BM + ai * HALF + wr * 64 + m * 16 + fr) * 1024 + col0;
#pragma unroll
                for (int bj = 0; bj < 2; ++bj)
#pragma unroll
                    for (int n = 0; n < 2; ++n) { const f32x4 xv = *(const f32x4*)(xin + off + bj * HALF + n * 16);
                        *(f32x4*)(out + off + bj * HALF + n * 16) = xv * alpha + g[bj][n] * acc[ai][bj][m][n]; } }
    }
};

template <class Epi, class Sched, bool ALIGN_EPI = false, bool SP2 = false>
__device__ __forceinline__ void gemm_phase(PG8_LAS unsigned char* lds, const Gemm g, const Sched& S, const Epi& E) {
    int tid_l = threadIdx.x; asm volatile("" : "+v"(tid_l));
    const int tid = tid_l, wid = __builtin_amdgcn_readfirstlane(tid >> 6), lane = tid & 63, wr = wid >> 2, wc = wid & 3, fr = lane & 15, fq = lane >> 4;
    const int K = g.K, nt = K / BK;
    unsigned voffA[2], voffB[2];
#pragma unroll
    for (int i = 0; i < 2; ++i) { int R, C; stage_rc(tid * 16 + i * 8192, R, C); const int Rb = Epi::PERM ? ((R & ~31) + perm32(R & 31)) : R;
        voffA[i] = (unsigned)(R * K + C) * 2u; voffB[i] = (unsigned)(Rb * K + C) * 2u; }
    const size_t kstep = (size_t)(BK * 2);
    const size_t hstep = (size_t)HALF * K * 2;
    const size_t tstep = 2 * hstep;
    const unsigned ldsw = (unsigned)wid * 1024u;
    const int aoff = lds_byte(wr * 64 + fr, fq * 8), boff = lds_byte(wc * 32 + fr, fq * 8);
#define PG8_SA(b, h) (((b) * 2 + (h)) * HTB)
#define PG8_SB(b, h) ((4 + (b) * 2 + (h)) * HTB)
#define PG8_STAGE(bufoff, gbase, voff) do { _Pragma("unroll") for (int _i = 0; _i < 2; ++_i) \
        __builtin_amdgcn_global_load_lds((const unsigned*)((const char*)(gbase) + (voff)[_i]), (PG8_LAS unsigned*)(lds + (bufoff) + ldsw + _i * 8192), 16, 0, 0); } while (0)
#define PG8_LDA(dst, b, h) do { _Pragma("unroll") for (int m = 0; m < 4; ++m) _Pragma("unroll") for (int k = 0; k < 2; ++k) dst[m][k] = *(const PG8_LAS bf16x8*)(lds + PG8_SA(b, h) + aoff + m * 2048 + k * 1024); } while (0)
#define PG8_LDB(dst, b, h) do { _Pragma("unroll") for (int n = 0; n < 2; ++n) _Pragma("unroll") for (int k = 0; k < 2; ++k) dst[n][k] = *(const PG8_LAS bf16x8*)(lds + PG8_SB(b, h) + boff + n * 2048 + k * 1024); } while (0)
#define PG8_MMA(ai, bj, At, Bt) do { __builtin_amdgcn_s_setprio(1); _Pragma("unroll") for (int m = 0; m < 4; ++m) _Pragma("unroll") for (int n = 0; n < 2; ++n) _Pragma("unroll") for (int k = 0; k < 2; ++k) \
        acc[ai][bj][m][n] = __builtin_amdgcn_mfma_f32_16x16x32_bf16(Bt[n][k], At[m][k], acc[ai][bj][m][n], 0, 0, 0); __builtin_amdgcn_s_setprio(0); } while (0)
#define PG8_WAIT_V(n) asm volatile("s_waitcnt vmcnt(" #n ")" ::: "memory")
#define PG8_WAIT_L(n) asm volatile("s_waitcnt lgkmcnt(" #n ")" ::: "memory")
#define PG8_BAR __builtin_amdgcn_s_barrier()
#define PG8_SCHED __builtin_amdgcn_sched_barrier(0)
    Unit cur, nxt; int ui = 0;
    if (!S.next(0, cur)) return;
    f32x4 acc[2][2][4][2];
#pragma unroll
    for (int a = 0; a < 2; ++a)
#pragma unroll
        for (int b = 0; b < 2; ++b)
#pragma unroll
            for (int m = 0; m < 4; ++m)
#pragma unroll
                for (int n = 0; n < 2; ++n) acc[a][b][m][n] = (f32x4){0.f, 0.f, 0.f, 0.f};
    bf16x8 At[4][2], B0[2][2], B1[2][2];
    const char* cA = (const char*)g.A + (size_t)cur.pm * tstep; const char* cB = (const char*)g.Bt + (size_t)cur.pn * tstep;
    S.a_ready(cur);
    if constexpr (SP2) {
        PG8_STAGE(PG8_SB(0, 0), cB, voffB); PG8_STAGE(PG8_SB(0, 1), cB + hstep, voffB); PG8_STAGE(PG8_SA(0, 0), cA, voffA); PG8_STAGE(PG8_SA(0, 1), cA + hstep, voffA);
        if (wr == 1) PG8_BAR;
        PG8_WAIT_V(2); PG8_BAR;
        PG8_STAGE(PG8_SB(1, 0), cB + kstep, voffB); PG8_STAGE(PG8_SA(1, 0), cA + kstep, voffA); PG8_STAGE(PG8_SB(1, 1), cB + hstep + kstep, voffB);
        PG8_WAIT_V(6); PG8_BAR;
    } else {
        PG8_STAGE(PG8_SB(0, 0), cB, voffB); PG8_STAGE(PG8_SA(0, 0), cA, voffA); PG8_STAGE(PG8_SB(0, 1), cB + hstep, voffB); PG8_STAGE(PG8_SA(0, 1), cA + hstep, voffA);
        if (wr == 1) PG8_BAR;
        PG8_WAIT_V(4); PG8_BAR;
        PG8_STAGE(PG8_SB(1, 0), cB + kstep, voffB); PG8_STAGE(PG8_SA(1, 0), cA + kstep, voffA); PG8_STAGE(PG8_SB(1, 1), cB + hstep + kstep, voffB);
        PG8_WAIT_V(6); PG8_BAR;
    }
    for (;;) {
        const bool has_next = S.next(ui + 1, nxt);
        const char* nA = has_next ? (const char*)g.A + (size_t)nxt.pm * tstep : cA; const char* nB = has_next ? (const char*)g.Bt + (size_t)nxt.pn * tstep : cB;
        for (int t = 0; t < nt; t += 2) {
            const bool last = (t == nt - 2);
            const char* a1 = cA + (size_t)(t + 1) * kstep;
            const char* a2 = last ? nA : cA + (size_t)(t + 2) * kstep; const char* b2 = last ? nB : cB + (size_t)(t + 2) * kstep;
            const char* a3 = a2 + kstep; const char* b3 = b2 + kstep;
            if (last && has_next) S.a_ready(nxt);
            if constexpr (SP2) {
            PG8_LDB(B0, 0, 0); PG8_LDB(B1, 0, 1); PG8_SCHED; PG8_LDA(At, 0, 0); PG8_STAGE(PG8_SA(1, 1), a1 + hstep, voffA);
            PG8_WAIT_V(8); PG8_WAIT_L(0); PG8_BAR; PG8_MMA(0, 0, At, B0); PG8_MMA(0, 1, At, B1); PG8_BAR; PG8_SCHED;
            PG8_LDA(At, 0, 1); PG8_STAGE(PG8_SB(0, 0), b2, voffB); PG8_STAGE(PG8_SB(0, 1), b2 + hstep, voffB); PG8_STAGE(PG8_SA(0, 0), a2, voffA);
            PG8_WAIT_V(8); PG8_WAIT_L(0); PG8_BAR; PG8_MMA(1, 0, At, B0); PG8_MMA(1, 1, At, B1); PG8_BAR; PG8_SCHED;
            PG8_LDB(B0, 1, 0); PG8_LDB(B1, 1, 1); PG8_SCHED; PG8_LDA(At, 1, 0); PG8_STAGE(PG8_SA(0, 1), a2 + hstep, voffA);
            PG8_WAIT_V(8); PG8_WAIT_L(0); PG8_BAR; PG8_MMA(0, 0, At, B0); PG8_MMA(0, 1, At, B1); PG8_BAR; PG8_SCHED;
            PG8_LDA(At, 1, 1); PG8_STAGE(PG8_SB(1, 0), b3, voffB); PG8_STAGE(PG8_SB(1, 1), b3 + hstep, voffB); PG8_STAGE(PG8_SA(1, 0), a3, voffA);
            PG8_WAIT_V(8); PG8_WAIT_L(0); PG8_BAR; PG8_MMA(1, 0, At, B0); PG8_MMA(1, 1, At, B1); PG8_BAR; PG8_SCHED;
            } else {
            PG8_LDB(B0, 0, 0); PG8_SCHED; PG8_LDA(At, 0, 0); PG8_STAGE(PG8_SA(1, 1), a1 + hstep, voffA);
            PG8_WAIT_L(8); PG8_BAR; PG8_WAIT_L(0); PG8_MMA(0, 0, At, B0); PG8_BAR; PG8_SCHED;
            PG8_LDB(B1, 0, 1); PG8_STAGE(PG8_SB(0, 0), b2, voffB);
            PG8_BAR; PG8_WAIT_L(0); PG8_MMA(0, 1, At, B1); PG8_BAR;
            PG8_LDA(At, 0, 1); PG8_STAGE(PG8_SA(0, 0), a2, voffA);
            PG8_BAR; PG8_WAIT_L(0); PG8_MMA(1, 0, At, B0); PG8_BAR; PG8_SCHED;
            PG8_STAGE(PG8_SB(0, 1), b2 + hstep, voffB);
            PG8_WAIT_V(6); PG8_BAR; PG8_MMA(1, 1, At, B1); PG8_BAR;
            PG8_LDB(B0, 1, 0); PG8_SCHED; PG8_LDA(At, 1, 0); PG8_STAGE(PG8_SA(0, 1), a2 + hstep, voffA);
            PG8_WAIT_L(8); PG8_BAR; PG8_WAIT_L(0); PG8_MMA(0, 0, At, B0); PG8_BAR; PG8_SCHED;
            PG8_LDB(B1, 1, 1); PG8_STAGE(PG8_SB(1, 0), b3, voffB);
            PG8_BAR; PG8_WAIT_L(0); PG8_MMA(0, 1, At, B1); PG8_BAR;
            PG8_LDA(At, 1, 1); PG8_STAGE(PG8_SA(1, 0), a3, voffA);
            PG8_BAR; PG8_WAIT_L(0); PG8_MMA(1, 0, At, B0); PG8_BAR; PG8_SCHED;
            PG8_STAGE(PG8_SB(1, 1), b3 + hstep, voffB);
            PG8_WAIT_V(6); PG8_BAR; PG8_MMA(1, 1, At, B1); PG8_BAR;
            }
        }
        if constexpr (ALIGN_EPI) { if (wr == 0) PG8_BAR; }
        if constexpr (!Epi::AFTER_DRAIN) { E(acc, cur, wr, wc, fr, fq); S.done(cur); }
        if (!has_next) break;
#pragma unroll
        for (int a = 0; a < 2; ++a)
#pragma unroll
            for (int b = 0; b < 2; ++b)
#pragma unroll
                for (int m = 0; m < 4; ++m)
#pragma unroll
                    for (int n = 0; n < 2; ++n) acc[a][b][m][n] = (f32x4){0.f, 0.f, 0.f, 0.f};
        cur = nxt; cA = nA; cB = nB; ++ui;
        if constexpr (ALIGN_EPI) { if (wr == 1) PG8_BAR; }
    }
    PG8_WAIT_V(0);
    if constexpr (!ALIGN_EPI) { if (wr == 0) PG8_BAR; }
    PG8_BAR;
    if constexpr (Epi::AFTER_DRAIN) { E.fused(acc, cur, wr, wc, fr, fq, lds, wid, lane); S.done(cur); }
#undef PG8_SA
#undef PG8_SB
#undef PG8_STAGE
#undef PG8_LDA
#undef PG8_LDB
#undef PG8_MMA
#undef PG8_WAIT_V
#undef PG8_WAIT_L
#undef PG8_BAR
#undef PG8_SCHED
}
}
#ifndef PG8_SP2
#define PG8_SP2 true
#endif
#ifndef PG8_ALIGN
#define PG8_ALIGN true
#endif
constexpr int NWAVES = 8;
#ifndef MK_PER_PHASE
#define MK_PER_PHASE 0
#endif
constexpr int BATCH = 8, SEQ = 2048, D = 1024, FF = 4096, DEPTH = 4;
constexpr int M = BATCH * SEQ;
constexpr int NQKV = 3 * D;
constexpr int MODW = 6 * D;
constexpr float LN_EPS = 1e-5f, SUBLN_EPS = 1e-5f;
constexpr float DN_ALPHA = 1.681792830507429f;
constexpr float QSCALE = 0.18033688011112042f;
#ifndef MK_CHECK
#define MK_CHECK 0
#endif
#ifndef MK_CHECK_THR
#define MK_CHECK_THR 2000u
#endif
constexpr int KPL = MK_CHECK ? 9 : 7;
constexpr int NPHASE = 2 + KPL * DEPTH;

constexpr size_t MiB = 1u << 20;
constexpr size_t WS_CTL = 0, CTL_ZERO_BYTES = 1 * MiB;
constexpr size_t WS_MOD = 1 * MiB;
constexpr size_t WS_ROPE = 2 * MiB;
constexpr size_t WS_KPART = 2 * MiB + 512 * 1024;
constexpr size_t WS_XCH = 3 * MiB;
constexpr size_t WS_W = 8 * MiB, W_LAYER = 24 * MiB;
constexpr size_t WOFF_IN = 0, WOFF_O = 6 * MiB, WOFF_UP = 8 * MiB, WOFF_DN = 16 * MiB;
constexpr size_t WS_Q = 104 * MiB, WS_K = 136 * MiB, WS_V = 168 * MiB, WS_O = 200 * MiB;
constexpr size_t WS_H = 104 * MiB;
constexpr size_t WS_HM = 232 * MiB;
constexpr size_t WS_DBG = 264 * MiB;
constexpr size_t WS_END = (MK_CHECK ? 296 : 264) * MiB;
static_assert(WS_V - WS_K == WS_K - WS_Q && WS_W + DEPTH * W_LAYER <= WS_Q && WS_H + (size_t)M * FF * 2 <= WS_HM && WS_HM + (size_t)M * D * 2 <= WS_END, "d_ws map");
constexpr int CW_TMO = 0, CW_CODE = 1, CW_CHK = 64;
constexpr int CW_BAR = 4096;
constexpr int CW_SEAM = 16384, SEAM_BANK = 128 * 64;

constexpr int RING_OFF = 0, RING_BYTES = 131072;
constexpr int LDSCTL_OFF = RING_BYTES, MISC_OFF = LDSCTL_OFF + 320;
constexpr int LDS_BYTES = 147456;
static_assert(MISC_OFF + 128 <= LDS_BYTES, "LDS map");

#include <hip/hip_bf16.h>
#include <cmath>
namespace attn_body {
using bf16=__hip_bfloat16;
using bf16x8=__attribute__((ext_vector_type(8)))short;
using s16x4=__attribute__((ext_vector_type(4)))short;
using f32x16=__attribute__((ext_vector_type(16)))float;
using u32x4=__attribute__((ext_vector_type(4)))unsigned;
constexpr int SEQ=2048,D=64,DM=1024;
constexpr int NW=8,QBLK=32,QB=QBLK*NW,KVBLK=64,NQB=SEQ/QB;
constexpr int ATTN_PITCH=DM, ATTN_UNIT_ROWS=QB;
__device__ __forceinline__ int crow(int r,int hi){return (r&3)+8*(r>>2)+4*hi;}
#define SBAR() __builtin_amdgcn_sched_barrier(0)
__device__ __forceinline__ void cmask(f32x16&p0,f32x16&p1,int jb,int qrel,int hi){
  const float NEG=-INFINITY; int thr=qrel-64*jb-4*hi; asm volatile("":"+v"(thr));
  #pragma unroll
  for(int r=0;r<16;++r){const int c=(r&3)+8*(r>>2); if(c>thr)p0[r]=NEG; if(c+32>thr)p1[r]=NEG;}
}

constexpr int NSLOT=3, SLOTB=8192;
constexpr int LDS_K=0, LDS_V=NSLOT*SLOTB, LDS_WS=2*NSLOT*SLOTB, LDS_OST=LDS_WS+NW*64*4, LDS_BYTES=LDS_OST+NW*4096;
constexpr float C2=0.125f*1.4426950408889634f;
__device__ __forceinline__ void glds16(const void*gsrc,unsigned lds_dst){unsigned keep;
  asm volatile("s_mov_b32 %0, m0\n\ts_mov_b32 m0, %2\n\ts_nop 0\n\tglobal_load_lds_dwordx4 %1, off\n\ts_mov_b32 m0, %0":"=&s"(keep):"v"(gsrc),"s"(lds_dst):"memory");}
__device__ __forceinline__ float max3f(float a,float b,float c){float r;asm("v_max3_f32 %0, %1, %2, %3":"=v"(r):"v"(a),"v"(b),"v"(c));return r;}
__device__ __forceinline__ float max2f(float a,float b){float r;asm("v_max_f32_e32 %0, %1, %2":"=v"(r):"v"(a),"v"(b));return r;}
__device__ __forceinline__ float fadd_s(float a,float b){float r;asm("v_add_f32_e32 %0, %1, %2":"=v"(r):"v"(a),"v"(b));return r;}
__device__ __forceinline__ float fsub_s(float a,float b){float r;asm("v_sub_f32_e32 %0, %1, %2":"=v"(r):"v"(a),"v"(b));return r;}
typedef float f32x2_t __attribute__((ext_vector_type(2))); typedef __bf16 bf16x2_t __attribute__((ext_vector_type(2)));
__device__ __forceinline__ unsigned cvtpk_s(float lo,float hi){f32x2_t v={lo,hi};bf16x2_t b=__builtin_convertvector(v,bf16x2_t);return __builtin_bit_cast(unsigned,b);}
#define WAIT_BAR(N) asm volatile("s_waitcnt vmcnt(" #N ") lgkmcnt(0)\n\ts_barrier":::"memory")

__device__ __forceinline__ void qkt(f32x16&p0,f32x16&p1,const char*Kslot,const bf16x8*qr,const f32x16&negm,int r32,int hi){
  const char*kb=Kslot+hi*1024+r32*16;
  #pragma unroll
  for(int d0=0;d0<4;++d0){
    const bf16x8 b0=*reinterpret_cast<const bf16x8*>(kb+d0*2048);
    const bf16x8 b1=*reinterpret_cast<const bf16x8*>(kb+d0*2048+512);
    if(d0==0){p0=__builtin_amdgcn_mfma_f32_32x32x16_bf16(b0,qr[0],negm,0,0,0);p1=__builtin_amdgcn_mfma_f32_32x32x16_bf16(b1,qr[0],negm,0,0,0);}
    else{p0=__builtin_amdgcn_mfma_f32_32x32x16_bf16(b0,qr[d0],p0,0,0,0);p1=__builtin_amdgcn_mfma_f32_32x32x16_bf16(b1,qr[d0],p1,0,0,0);}}
}
typedef __attribute__((address_space(3))) const char* lds_cptr;
typedef short v4i16_t __attribute__((ext_vector_type(4)));
__device__ __forceinline__ void kload8(bf16x8*kf,lds_cptr kp){
  kf[0]=*(const __attribute__((address_space(3))) bf16x8*)(kp);      kf[1]=*(const __attribute__((address_space(3))) bf16x8*)(kp+512);
  kf[2]=*(const __attribute__((address_space(3))) bf16x8*)(kp+2048); kf[3]=*(const __attribute__((address_space(3))) bf16x8*)(kp+2560);
  kf[4]=*(const __attribute__((address_space(3))) bf16x8*)(kp+4096); kf[5]=*(const __attribute__((address_space(3))) bf16x8*)(kp+4608);
  kf[6]=*(const __attribute__((address_space(3))) bf16x8*)(kp+6144); kf[7]=*(const __attribute__((address_space(3))) bf16x8*)(kp+6656);
}
__device__ __forceinline__ void kload2(bf16x8*kf,lds_cptr kp,int j){ kf[2*j]=*(const __attribute__((address_space(3))) bf16x8*)(kp+j*2048); kf[2*j+1]=*(const __attribute__((address_space(3))) bf16x8*)(kp+j*2048+512); }
__device__ __forceinline__ s16x4 vtr(lds_cptr p){ return __builtin_bit_cast(s16x4,__builtin_amdgcn_ds_read_tr16_b64_v4i16((__attribute__((address_space(3))) v4i16_t*)p)); }
__device__ __forceinline__ float rowmax(const f32x16&p0,const f32x16&p1){
  float a=max3f(p0[0],p0[1],p1[0]),b=max3f(p0[2],p0[3],p1[1]);a=max3f(a,p1[2],p1[3]);
  #pragma unroll
  for(int r=4;r<16;r+=4){a=max3f(a,p0[r],p0[r+1]);b=max3f(b,p0[r+2],p0[r+3]);a=max3f(a,p1[r],p1[r+1]);b=max3f(b,p1[r+2],p1[r+3]);}
  const float m=max2f(a,b);
  auto rr=__builtin_amdgcn_permlane32_swap(__float_as_uint(m),__float_as_uint(m),false,false);
  return max2f(__uint_as_float(rr[0]),__uint_as_float(rr[1]));
}
__device__ __forceinline__ void pv(f32x16*o,int vb,bf16x8 pa0,bf16x8 pa1,bf16x8 pa2,bf16x8 pa3){
  #pragma unroll
  for(int d0=0;d0<2;++d0){s16x4 lo[4],hi[4];
    #pragma unroll
    for(int ks=0;ks<4;++ks){
      asm volatile("ds_read_b64_tr_b16 %0,%1 offset:%c2":"=&v"(lo[ks]):"v"(vb),"i"(d0*4096+ks*1024):"memory");
      asm volatile("ds_read_b64_tr_b16 %0,%1 offset:%c2":"=&v"(hi[ks]):"v"(vb),"i"(d0*4096+ks*1024+512):"memory");}
    asm volatile("s_waitcnt lgkmcnt(0)":::"memory");SBAR();
    #define PK(k) (bf16x8){lo[k][0],lo[k][1],lo[k][2],lo[k][3],hi[k][0],hi[k][1],hi[k][2],hi[k][3]}
    o[d0]=__builtin_amdgcn_mfma_f32_32x32x16_bf16(pa0,PK(0),o[d0],0,0,0);
    o[d0]=__builtin_amdgcn_mfma_f32_32x32x16_bf16(pa1,PK(1),o[d0],0,0,0);
    o[d0]=__builtin_amdgcn_mfma_f32_32x32x16_bf16(pa2,PK(2),o[d0],0,0,0);
    o[d0]=__builtin_amdgcn_mfma_f32_32x32x16_bf16(pa3,PK(3),o[d0],0,0,0);
    #undef PK
  }
}

#ifndef ATTN_STORE16
#define ATTN_STORE16(p,v) (*(u32x4*)(p)=(v))
#endif
template<int THRL,bool MOBA> __device__ __forceinline__ void attn_unit(int b,int qb,const bf16*Q,const bf16*__restrict__ K,const bf16*__restrict__ V,bf16*O,int OP,const float*kpart,char*shm){
  int tid_l=threadIdx.x; asm volatile("":"+v"(tid_l));
  const int tid=tid_l,lane=tid&63,r32=lane&31,hi=lane>>5; const int wid=__builtin_amdgcn_readfirstlane(tid>>6);
  const long rowbase=(long)b*SEQ; const int q0=qb*QB;
  const bf16*Qw=Q+(rowbase+q0+wid*QBLK)*DM;
  const bf16*Kh=K+rowbase*DM,*Vh=V+rowbase*DM;
  const unsigned lds0=(unsigned)(uintptr_t)shm;
  float*wsf=(float*)(shm+LDS_WS)+wid*64;
  const bf16*ksrc=Kh+(long)lane*DM+wid*8;
  const bf16*vsrc=Vh+(long)(16*(wid&3)+(lane>>2))*DM+(wid>>2)*32+(lane&3)*8;
  const unsigned kdst=lds0+LDS_K+wid*1024, vdst=lds0+LDS_V+wid*1024;
  #define TM(t) (MOBA?(((t)<4)?(4*qb+(t)):((t)-4)):(t))
  #define DMA_K(t,slot) glds16(ksrc+(long)TM(t)*KVBLK*DM,(unsigned)__builtin_amdgcn_readfirstlane(kdst+(slot)))
  #define DMA_V(t,slot) glds16(vsrc+(long)TM(t)*KVBLK*DM,(unsigned)__builtin_amdgcn_readfirstlane(vdst+(slot)))
  const int vb0=(int)(lds0+LDS_V)+((lane>>4)&1)*32+(lane&3)*8+(4*hi+((lane&15)>>2))*64;
  const char*Kbase=shm+LDS_K; bf16x8 kf[8];
  const lds_cptr shm3=(lds_cptr)shm; const lds_cptr kp0=shm3+LDS_K+hi*1024+r32*16; const lds_cptr vp0=shm3+LDS_V+((lane>>4)&1)*32+(lane&3)*8+(4*hi+((lane&15)>>2))*64;
  const int NT=(q0+QB)/KVBLK;
  DMA_K(0,0);DMA_V(0,0);DMA_K(1,SLOTB);
  bf16x8 qr[4];
  #pragma unroll
  for(int d0=0;d0<4;++d0)qr[d0]=*reinterpret_cast<const bf16x8*>(&Qw[(long)r32*DM+d0*16+hi*8]);
  float mhat=0.f,l_reg=0.f;f32x16 o[2];o[0]=f32x16{};o[1]=f32x16{};f32x16 negm=f32x16{};asm volatile("":"+v"(negm));
  const int qrel=wid*QBLK+r32;
  unsigned selbits=0xffu;
  if(MOBA&&qb>=4){
    f32x16 gacc=f32x16{}; int ro=r32; asm volatile("":"+v"(ro));
    #pragma unroll
    for(int d0=0;d0<4;++d0){ float kv[8];
      #pragma unroll
      for(int j=0;j<8;++j)kv[j]=0.f;
      if(ro<qb){ const float*kp=kpart+(long)(ro*2)*1024+d0*16+hi*8;
        #pragma unroll
        for(int j=0;j<8;++j)kv[j]=kp[j]+kp[1024+j]; }
      bf16x8 kh,kl;
      #pragma unroll
      for(int j=0;j<8;++j){ const unsigned hb=__float_as_uint(kv[j])&0xffff0000u; kh[j]=(short)(hb>>16); const float rem=kv[j]-__uint_as_float(hb); kl[j]=(short)(__float_as_uint(rem)>>16); }
      gacc=__builtin_amdgcn_mfma_f32_32x32x16_bf16(kh,qr[d0],gacc,0,0,0); gacc=__builtin_amdgcn_mfma_f32_32x32x16_bf16(kl,qr[d0],gacc,0,0,0); }
    float g[8];
    #pragma unroll
    for(int n=0;n<4;++n){ const float own=gacc[n], oth=__shfl_xor(own,32); g[n]=hi?oth:own; g[4+n]=hi?own:oth; }
    unsigned sb=0u;
    #pragma unroll
    for(int n=0;n<8;++n){ int rank=0;
      #pragma unroll
      for(int m=0;m<8;++m) if(m!=n) rank+=((m<qb)&&((g[m]>g[n])||((g[m]==g[n])&&(m<n))))?1:0;
      if((n<qb)&&(rank<3)) sb|=1u<<n; }
    selbits=sb; }
  #define CMASK(P0,P1,t) do{ const int jb_=MOBA?(t):((t)-(NT-4)); if(jb_>=0&&jb_<4){cmask(P0,P1,jb_,qrel,hi);} \
    else if(MOBA&&qb>=4){ if(!((selbits>>((((t)-4)>>2)&7))&1u)){ _Pragma("unroll") for(int r=0;r<16;++r){P0[r]=-INFINITY;P1[r]=-INFINITY;} } } }while(0)
  bool resc=false;
  #define START(P0,P1) do{ const float rm=rowmax(P0,P1); resc=false; \
    { const float dl=rm; mhat=fadd_s(mhat,dl); \
      _Pragma("unroll") for(int r=0;r<16;++r){P0[r]=fsub_s(P0[r],dl);P1[r]=fsub_s(P1[r],dl);} \
      _Pragma("unroll") for(int r=0;r<16;++r)negm[r]=-mhat; asm volatile("":"+v"(negm)); } \
    _Pragma("unroll") for(int r=0;r<16;++r)P0[r]=__builtin_amdgcn_exp2f(P0[r]); }while(0)
  #define RESC() do{ if(resc){ asm volatile("s_waitcnt lgkmcnt(0)":::"memory"); \
      _Pragma("unroll") for(int d_=0;d_<2;++d_) _Pragma("unroll") for(int r=0;r<16;++r)o[d_][r]*=wsf[crow(r,hi)]; } }while(0)
  f32x16 pA0,pA1,pB0,pB1;
  int sl_prev=0,sl_cur=0,sl_next=SLOTB;
  #define ROT() do{sl_prev=sl_cur;sl_cur=sl_next;sl_next=(sl_next==(NSLOT-1)*SLOTB)?0:sl_next+SLOTB;}while(0)
  DMA_K(2,2*SLOTB);
  WAIT_BAR(3);
  qkt(pA0,pA1,Kbase,qr,negm,r32,hi);asm volatile("s_nop 15\n\ts_nop 7":"+v"(pA0),"+v"(pA1));CMASK(pA0,pA1,0);
  START(pA0,pA1);
  _Pragma("unroll") for(int r=0;r<16;++r)pA1[r]=__builtin_amdgcn_exp2f(pA1[r]);
  WAIT_BAR(0);
  DMA_K(3,0);DMA_V(1,SLOTB);
  ROT();
  kload8(kf,kp0+sl_cur);
  WAIT_BAR(2);
  s16x4 vlo[8],vhi[8]; u32x4 pw0,pw1,pw2,pw3;
  #define PKW(P,B) cvtpk_s(P[B],P[B+1])
  #define PAF(k) __builtin_bit_cast(bf16x8,pw##k)
  #define VFR(i) (bf16x8){vlo[i][0],vlo[i][1],vlo[i][2],vlo[i][3],vhi[i][0],vhi[i][1],vhi[i][2],vhi[i][3]}
  #define PIN(x) asm volatile("":"+v"(x))
  #define MX3(a,b,c) __builtin_fmaxf(__builtin_fmaxf((a),(b)),(c))
  #define GAPA(MF,A0,A1,A2,A3,W0,W1,PW) do{ MF; sacc+=A0; sacc+=A1; sacc+=A2; sacc+=A3; PIN(sacc); W0; W1; PIN(PW); SBAR(); }while(0)
  #define EX(v) __builtin_amdgcn_exp2f(v)
  #define GAPB(MF,X,B) do{ MF; X[B]=EX(X[B]); X[B+1]=EX(X[B+1]); X[B+2]=EX(X[B+2]); X[B+3]=EX(X[B+3]); PIN(X); SBAR(); }while(0)
  #define VRD(i) do{ vlo[i]=vtr(vp_+(((i)>>2)*4096+((i)&3)*1024)); vhi[i]=vtr(vp_+(((i)>>2)*4096+((i)&3)*1024+512)); }while(0)
  #define KRD(G,j) do{ if(G){ kload2(kf,kp0+sl_next,j); SBAR(); } }while(0)
  #define STEP(C0,C1,P0,P1,t,GK,GV,GL) do{ SBAR(); \
    const lds_cptr vp_=vp0+sl_prev; \
    VRD(0); SBAR(); float sacc=(P0[0]+P0[1]); \
    GAPA(C0=__builtin_amdgcn_mfma_f32_32x32x16_bf16(kf[0],qr[0],negm,0,0,0), P0[2],P0[3],P0[4],P0[5],     pw0[0]=PKW(P0,0), pw0[1]=PKW(P0,2), pw0); \
    VRD(4); SBAR(); GAPA(C1=__builtin_amdgcn_mfma_f32_32x32x16_bf16(kf[1],qr[0],negm,0,0,0), P0[6],P0[7],P0[8],P0[9],     pw0[2]=PKW(P0,4), pw0[3]=PKW(P0,6), pw0); \
    VRD(1); SBAR(); GAPA(C0=__builtin_amdgcn_mfma_f32_32x32x16_bf16(kf[2],qr[1],C0,0,0,0),   P0[10],P0[11],P0[12],P0[13], pw1[0]=PKW(P0,8), pw1[1]=PKW(P0,10), pw1); \
    VRD(5); SBAR(); GAPA(C1=__builtin_amdgcn_mfma_f32_32x32x16_bf16(kf[3],qr[1],C1,0,0,0),   P0[14],P0[15],P1[0],P1[1],   pw1[2]=PKW(P0,12),pw1[3]=PKW(P0,14), pw1); \
    VRD(2); SBAR(); GAPA(C0=__builtin_amdgcn_mfma_f32_32x32x16_bf16(kf[4],qr[2],C0,0,0,0),   P1[2],P1[3],P1[4],P1[5],     pw2[0]=PKW(P1,0), pw2[1]=PKW(P1,2), pw2); \
    VRD(6); SBAR(); GAPA(C1=__builtin_amdgcn_mfma_f32_32x32x16_bf16(kf[5],qr[2],C1,0,0,0),   P1[6],P1[7],P1[8],P1[9],     pw2[2]=PKW(P1,4), pw2[3]=PKW(P1,6), pw2); \
    VRD(3); SBAR(); GAPA(C0=__builtin_amdgcn_mfma_f32_32x32x16_bf16(kf[6],qr[3],C0,0,0,0),   P1[10],P1[11],P1[12],P1[13], pw3[0]=PKW(P1,8), pw3[1]=PKW(P1,10), pw3); \
    VRD(7); SBAR(); GAPA(C1=__builtin_amdgcn_mfma_f32_32x32x16_bf16(kf[7],qr[3],C1,0,0,0),   P1[14],P1[15],0.f,0.f,       pw3[2]=PKW(P1,12),pw3[3]=PKW(P1,14), pw3); \
    l_reg+=sacc; \
    if(GK){DMA_K((t)+3,sl_cur);} if(GV){DMA_V((t)+1,sl_next);} \
    CMASK(C0,C1,t); \
    { float a=MX3(C0[0],C0[1],C1[0]),b=MX3(C0[2],C0[3],C1[1]); a=MX3(a,C1[2],C1[3]); \
      _Pragma("unroll") for(int r=4;r<16;r+=4){a=MX3(a,C0[r],C0[r+1]);b=MX3(b,C0[r+2],C0[r+3]);a=MX3(a,C1[r],C1[r+1]);b=MX3(b,C1[r+2],C1[r+3]);} \
      float rm=__builtin_fmaxf(a,b); { auto rr=__builtin_amdgcn_permlane32_swap(__float_as_uint(rm),__float_as_uint(rm),false,false); rm=__builtin_fmaxf(__uint_as_float(rr[0]),__uint_as_float(rr[1])); } \
      resc=false; \
      if(__builtin_expect(__any(rm>(float)THRL),0)){ const float dl=__builtin_fmaxf(rm,0.f); mhat+=dl; \
        _Pragma("unroll") for(int r=0;r<16;++r){C0[r]-=dl;C1[r]-=dl;} \
        _Pragma("unroll") for(int r=0;r<16;++r)negm[r]=-mhat; asm volatile("":"+v"(negm)); \
        const float f=__builtin_amdgcn_exp2f(-dl); l_reg*=f; if(hi==0)wsf[r32]=f; resc=true; } } \
    SBAR(); \
    GAPB(o[0]=__builtin_amdgcn_mfma_f32_32x32x16_bf16(PAF(0),VFR(0),o[0],0,0,0), C0,0); \
    GAPB(o[1]=__builtin_amdgcn_mfma_f32_32x32x16_bf16(PAF(0),VFR(4),o[1],0,0,0), C0,4); \
    KRD(GL,0); GAPB(o[0]=__builtin_amdgcn_mfma_f32_32x32x16_bf16(PAF(1),VFR(1),o[0],0,0,0), C0,8); \
    KRD(GL,1); GAPB(o[1]=__builtin_amdgcn_mfma_f32_32x32x16_bf16(PAF(1),VFR(5),o[1],0,0,0), C0,12); \
    KRD(GL,2); GAPB(o[0]=__builtin_amdgcn_mfma_f32_32x32x16_bf16(PAF(2),VFR(2),o[0],0,0,0), C1,0); \
    KRD(GL,3); GAPB(o[1]=__builtin_amdgcn_mfma_f32_32x32x16_bf16(PAF(2),VFR(6),o[1],0,0,0), C1,4); \
    GAPB(o[0]=__builtin_amdgcn_mfma_f32_32x32x16_bf16(PAF(3),VFR(3),o[0],0,0,0), C1,8); \
    GAPB(o[1]=__builtin_amdgcn_mfma_f32_32x32x16_bf16(PAF(3),VFR(7),o[1],0,0,0), C1,12); \
    }while(0)
  int t=1;
  for(;t+5<NT;t+=2){
    STEP(pB0,pB1,pA0,pA1,t,true,true,true);     WAIT_BAR(2); RESC(); ROT();
    STEP(pA0,pA1,pB0,pB1,t+1,true,true,true);   WAIT_BAR(2); RESC(); ROT();
  }
  #define ENDW(tt) do{ if((tt)+3<NT){WAIT_BAR(2);} else if((tt)+2<NT){WAIT_BAR(1);} else {WAIT_BAR(0);} }while(0)
  for(;t+1<NT;t+=2){
    STEP(pB0,pB1,pA0,pA1,t,(t+3<NT),(t+1<NT),(t+1<NT));       ENDW(t);   RESC(); ROT();
    STEP(pA0,pA1,pB0,pB1,t+1,(t+4<NT),(t+2<NT),(t+2<NT));     ENDW(t+1); RESC(); ROT();
  }
  STEP(pB0,pB1,pA0,pA1,NT-1,false,false,false); RESC();
  { float sacc=pB0[0]+pB0[1]; _Pragma("unroll") for(int r=2;r<16;++r)sacc+=pB0[r]; _Pragma("unroll") for(int r=0;r<16;++r)sacc+=pB1[r]; l_reg+=sacc;
    pw0=(u32x4){PKW(pB0,0),PKW(pB0,2),PKW(pB0,4),PKW(pB0,6)};pw1=(u32x4){PKW(pB0,8),PKW(pB0,10),PKW(pB0,12),PKW(pB0,14)};pw2=(u32x4){PKW(pB1,0),PKW(pB1,2),PKW(pB1,4),PKW(pB1,6)};pw3=(u32x4){PKW(pB1,8),PKW(pB1,10),PKW(pB1,12),PKW(pB1,14)};
    SBAR(); pv(o,vb0+sl_cur,PAF(0),PAF(1),PAF(2),PAF(3)); }
  #undef PKW
  #undef PAF
  #undef VFR
  #undef PIN
  #undef MX3
  #undef GAPA
  #undef GAPB
  #undef EX
  #undef VRD
  #undef KRD
  #undef STEP
  #undef ENDW
  {auto rr=__builtin_amdgcn_permlane32_swap(__float_as_uint(l_reg),__float_as_uint(l_reg),false,false);l_reg=__uint_as_float(rr[0])+__uint_as_float(rr[1]);}
  if(hi==0)wsf[32+r32]=l_reg;asm volatile("s_waitcnt lgkmcnt(0)":::"memory");
  float rli[16];
  #pragma unroll
  for(int r=0;r<16;++r)rli[r]=__builtin_amdgcn_rcpf(wsf[32+crow(r,hi)]);
  bf16*Ow=O+(rowbase+q0+wid*QBLK)*(long)OP;
  { bf16*stg=(bf16*)(shm+LDS_OST)+wid*2048;
    #pragma unroll
    for(int r=0;r<16;++r){const int orow=crow(r,hi);
      #pragma unroll
      for(int d0=0;d0<2;++d0)stg[orow*64+d0*32+r32]=__float2bfloat16(o[d0][r]*rli[r]);}
    asm volatile("s_waitcnt lgkmcnt(0)":::"memory");
    #pragma unroll
    for(int i=0;i<4;++i){const int row=i*8+(lane>>3),ch=lane&7; const u32x4 v=*(const u32x4*)(stg+row*64+ch*8); ATTN_STORE16(Ow+(long)row*OP+ch*8,v);} }
  asm volatile("s_waitcnt lgkmcnt(0)\n\ts_barrier":::"memory");
  #undef DMA_K
  #undef TM
  #undef DMA_V
  #undef CMASK
  #undef START
  #undef RESC
  #undef ROT
}
constexpr int ATTN_LDS_BYTES=LDS_BYTES;
#undef SBAR
#undef WAIT_BAR
}
#define GAS __attribute__((address_space(1)))
#define LAS __attribute__((address_space(3)))
typedef unsigned short bf16;
typedef unsigned v4u __attribute__((ext_vector_type(4)));
typedef float f32x4 __attribute__((ext_vector_type(4)));
typedef short bf16x8 __attribute__((ext_vector_type(8)));
typedef GAS unsigned gu32;
typedef GAS unsigned long long gu64;
#define RLX_AGENT __ATOMIC_RELAXED, __HIP_MEMORY_SCOPE_AGENT
#define LDS_WAIT() asm volatile("s_waitcnt lgkmcnt(0)" ::: "memory")
#define VM_WAIT() asm volatile("s_waitcnt vmcnt(0)" ::: "memory")
__device__ __forceinline__ unsigned long long rt() { return __builtin_amdgcn_s_memrealtime(); }
__device__ __forceinline__ unsigned f2bf(float f) { unsigned u = __builtin_bit_cast(unsigned, f); return (u + 0x7fffu + ((u >> 16) & 1u)) >> 16; }
__device__ __forceinline__ unsigned pk2(float lo, float hi) { return f2bf(lo) | (f2bf(hi) << 16); }

#define XB_TMO      128
#define XB_XCNT(j)  (256  + 64 * (j))
#define XB_XSUB(j)  (1280 + 64 * (j))
#define XB_XGEN(j)  (2304 + 64 * (j))
#define XB_TOP      3328
#define XB_TOPGEN   3392
#define XCD_BAR_WORDS 3456
#define XB_SPIN_CAP (1u << 23)

__device__ __forceinline__ unsigned xb_ld(unsigned* p)              { return __hip_atomic_load(p, __ATOMIC_RELAXED, __HIP_MEMORY_SCOPE_AGENT); }
__device__ __forceinline__ unsigned xb_add(unsigned* p, unsigned v) { return __hip_atomic_fetch_add(p, v, __ATOMIC_RELAXED, __HIP_MEMORY_SCOPE_AGENT); }
__device__ __forceinline__ unsigned xb_xcc_id() { return (unsigned)__builtin_amdgcn_s_getreg((3 << 11) | 20) & 0xFu; }
#define XB_SPIN(cond, bar) do { unsigned _sp = 0; while (cond) { __builtin_amdgcn_s_sleep(1); \
    if ((++_sp & 255u) == 0u) { if (xb_ld(&(bar)[XB_TMO])) break; if (_sp > XB_SPIN_CAP) { atomicAdd(&(bar)[XB_TMO], 1u); break; } } } } while (0)

struct XcdBarrier {
    unsigned* bar; unsigned x;
    volatile LAS unsigned* st;
};

__device__ __forceinline__ XcdBarrier xcd_barrier_post(unsigned* bar, volatile LAS unsigned* st) {
    XcdBarrier b; b.bar = bar; b.x = xb_xcc_id(); b.st = st;
    if (threadIdx.x == 0) (void)xb_add(&bar[XB_XCNT(b.x)], 1u);
    return b;
}
__device__ __forceinline__ void xcd_barrier_complete(unsigned* bar, unsigned x, unsigned& nloc, unsigned& nx) {
    const unsigned G = gridDim.x * gridDim.y * gridDim.z;
    unsigned sum, cnt, mine, sp = 0u;
    for (;;) {
        sum = 0u; cnt = 0u; mine = 0u;
#pragma unroll
        for (unsigned j = 0; j < 16; ++j) { const unsigned c = xb_ld(&bar[XB_XCNT(j)]); sum += c; cnt += (c > 0u) ? 1u : 0u; mine = (j == x) ? c : mine; }
        if (sum == G) break;
        __builtin_amdgcn_s_sleep(1);
        if ((++sp & 255u) == 0u) { if (xb_ld(&bar[XB_TMO])) break; if (sp > XB_SPIN_CAP) { atomicAdd(&bar[XB_TMO], 1u); break; } }
    }
    nloc = mine > 0u ? mine : 1u; nx = cnt > 0u ? cnt : 1u;
}

__device__ __forceinline__ void xcd_barrier(const XcdBarrier& b) {
    asm volatile("s_waitcnt vmcnt(0)" ::: "memory");
    __syncthreads();
    if (threadIdx.x == 0) {
        unsigned* bar = b.bar;
        __builtin_amdgcn_s_waitcnt(0);
        unsigned nloc = b.st[0], nx = b.st[1];
        if (nloc == 0u) { xcd_barrier_complete(bar, b.x, nloc, nx); b.st[0] = nloc; b.st[1] = nx; }
        const unsigned old = xb_add(&bar[XB_XSUB(b.x)], 1u);
        const unsigned gen = old / nloc;
        if (old + 1u == (gen + 1u) * nloc) {
            __builtin_amdgcn_fence(__ATOMIC_RELEASE, "agent");
            asm volatile("s_waitcnt vmcnt(0)" ::: "memory");
            const unsigned og = xb_add(&bar[XB_TOP], 1u);
            const unsigned tg = og / nx;
            if (og + 1u == (tg + 1u) * nx) xb_add(&bar[XB_TOPGEN], 1u);
            else XB_SPIN(xb_ld(&bar[XB_TOPGEN]) == tg, bar);
            __builtin_amdgcn_fence(__ATOMIC_ACQUIRE, "agent");
            xb_add(&bar[XB_XGEN(b.x)], 1u);
            asm volatile("s_waitcnt vmcnt(0)" ::: "memory");
        } else {
            XB_SPIN(xb_ld(&bar[XB_XGEN(b.x)]) == gen, bar);
            __builtin_amdgcn_fence(__ATOMIC_ACQUIRE, "agent");
            asm volatile("s_waitcnt vmcnt(0)" ::: "memory");
        }
    }
    __syncthreads();
}

struct Args { const float* in[17]; float* out; unsigned char* ws; int ph_lo, ph_hi; };
struct Frame {
    LAS unsigned char* lds;
    char* ldsg;
    volatile LAS unsigned* MISC;
    gu32* ctl;
    int vcu, G;
    const struct Args* a;
    unsigned char* ws;
    int z;
};
#define F_X ((const float*)(const GAS float*)(unsigned long long)(F.a->in[0 + F.z]))
#define F_C ((const float*)(const GAS float*)(unsigned long long)(F.a->in[1 + F.z]))
#define F_MOBA_W_IN ((const float*)(const GAS float*)(unsigned long long)(F.a->in[2 + F.z]))
#define F_MOBA_W_OUT ((const float*)(const GAS float*)(unsigned long long)(F.a->in[3 + F.z]))
#define F_DIFF_W_IN ((const float*)(const GAS float*)(unsigned long long)(F.a->in[4 + F.z]))
#define F_DIFF_W_OUT ((const float*)(const GAS float*)(unsigned long long)(F.a->in[5 + F.z]))
#define F_LAM_Q1 ((const float*)(const GAS float*)(unsigned long long)(F.a->in[6 + F.z]))
#define F_LAM_K1 ((const float*)(const GAS float*)(unsigned long long)(F.a->in[7 + F.z]))
#define F_LAM_Q2 ((const float*)(const GAS float*)(unsigned long long)(F.a->in[8 + F.z]))
#define F_LAM_K2 ((const float*)(const GAS float*)(unsigned long long)(F.a->in[9 + F.z]))
#define F_SUBLN_G ((const float*)(const GAS float*)(unsigned long long)(F.a->in[10 + F.z]))
#define F_ADA_W ((const float*)(const GAS float*)(unsigned long long)(F.a->in[11 + F.z]))
#define F_ADA_B ((const float*)(const GAS float*)(unsigned long long)(F.a->in[12 + F.z]))
#define F_LN_G ((const float*)(const GAS float*)(unsigned long long)(F.a->in[13 + F.z]))
#define F_LN_B ((const float*)(const GAS float*)(unsigned long long)(F.a->in[14 + F.z]))
#define F_W_UP ((const float*)(const GAS float*)(unsigned long long)(F.a->in[15 + F.z]))
#define F_W_DOWN ((const float*)(const GAS float*)(unsigned long long)(F.a->in[16 + F.z]))
#define F_OUT ((float*)(GAS float*)(unsigned long long)((&F.a->out)[F.z]))
#define F_MOD ((float*)(F.ws + WS_MOD))
#define F_ROPE ((float*)(F.ws + WS_ROPE))
#define F_KPART ((float*)(F.ws + WS_KPART))
#define F_Q ((bf16*)(F.ws + WS_Q))
#define F_K ((bf16*)(F.ws + WS_K))
#define F_V ((bf16*)(F.ws + WS_V))
#define F_O ((bf16*)(F.ws + WS_O))
#define F_H ((bf16*)(F.ws + WS_H))
#define F_HM ((bf16*)(F.ws + WS_HM))
__device__ __forceinline__ bf16* w_in_t(Frame& F, int l) { return (bf16*)(F.ws + WS_W + (size_t)l * W_LAYER + WOFF_IN); }
__device__ __forceinline__ bf16* w_o_t(Frame& F, int l)  { return (bf16*)(F.ws + WS_W + (size_t)l * W_LAYER + WOFF_O); }
__device__ __forceinline__ bf16* w_up_t(Frame& F, int l) { return (bf16*)(F.ws + WS_W + (size_t)l * W_LAYER + WOFF_UP); }
__device__ __forceinline__ bf16* w_dn_t(Frame& F, int l) { return (bf16*)(F.ws + WS_W + (size_t)l * W_LAYER + WOFF_DN); }

#define PHASE_IDS int tid_l_ = threadIdx.x; asm volatile("" : "+v"(tid_l_)); const int tid = tid_l_, lane = tid & 63, wave = __builtin_amdgcn_readfirstlane(tid >> 6); (void)tid; (void)lane; (void)wave
__device__ __forceinline__ float wave_sum(float v) {
#pragma unroll
    for (int o = 1; o < 64; o <<= 1) v += __shfl_xor(v, o);
    return v;
}
__device__ __forceinline__ float wave_max(float v) {
#pragma unroll
    for (int o = 1; o < 64; o <<= 1) v = fmaxf(v, __shfl_xor(v, o));
    return v;
}
__device__ __forceinline__ float bf2f(bf16 h) { return __builtin_bit_cast(float, (unsigned)h << 16); }
__device__ __forceinline__ void p0_transpose_item(const float* W, int K, int N, bf16* WT, int row_off, LAS float* scr, int item, int lane) {
    const int nblk = N / 32, kb = item / nblk, nb = item % nblk, k0 = 64 * kb, n0 = 32 * nb;
#pragma unroll 8
    for (int i = 0; i < 32; ++i) { const int kk = 2 * i + (lane >> 5); scr[kk * 33 + (lane & 31)] = W[(size_t)(k0 + kk) * N + n0 + (lane & 31)]; }
    LDS_WAIT(); asm volatile("" ::: "memory");
    const int c = lane & 7;
#pragma unroll
    for (int j = 0; j < 4; ++j) { const int n = (lane >> 3) + 8 * j; const LAS float* s = scr + (8 * c) * 33 + n;
        v4u o; o.x = pk2(s[0 * 33], s[1 * 33]); o.y = pk2(s[2 * 33], s[3 * 33]); o.z = pk2(s[4 * 33], s[5 * 33]); o.w = pk2(s[6 * 33], s[7 * 33]);
        *(GAS v4u*)(WT + (size_t)(row_off + n0 + n) * K + k0 + 8 * c) = o; }
    LDS_WAIT(); asm volatile("" ::: "memory");
}
__device__ __forceinline__ void sincos_f(float a, float& s, float& c) {
    const float kq = rintf(a * 0.636619772367581343f);
    float r = fmaf(-kq, 1.5703125f, a);
    r = fmaf(-kq, 4.837512969970703125e-4f, r);
    r = fmaf(-kq, 7.54978995489188e-8f, r);
    const float r2 = r * r;
    float sp = 2.7557319e-6f; sp = fmaf(sp, r2, -1.9841270e-4f); sp = fmaf(sp, r2, 8.3333333e-3f); sp = fmaf(sp, r2, -1.6666667e-1f); sp = fmaf(sp, r2, 1.0f);
    const float sr = r * sp;
    float cp = -2.7557319e-7f; cp = fmaf(cp, r2, 2.4801587e-5f); cp = fmaf(cp, r2, -1.3888889e-3f); cp = fmaf(cp, r2, 4.1666667e-2f); cp = fmaf(cp, r2, -0.5f); cp = fmaf(cp, r2, 1.0f);
    const int q = (int)kq & 3;
    s = (q == 0) ? sr : (q == 1) ? cp : (q == 2) ? -sr : -cp;
    c = (q == 0) ? cp : (q == 1) ? -sr : (q == 2) ? -cp : sr;
}
__device__ __forceinline__ float rope_inv(int j) {
    return j == 0 ? 1.0f : j == 1 ? 0.19392274474868576f : j == 2 ? 0.03760603093086393f : j == 3 ? 0.007292664737217109f : j == 4 ? 0.001414213562373095f
         : j == 5 ? 0.0002742481756762073f : j == 6 ? 5.318295896944988e-05f : 1.031338537721246e-05f;
}
__device__ __forceinline__ void p0_prologue(Frame& F) {
    PHASE_IDS;
    LAS float* scr = (LAS float*)(F.lds + RING_OFF + wave * 16384);
    const int gw = F.vcu * NWAVES + wave, NGW = F.G * NWAVES;
    constexpr int I_IN = (D / 64) * (NQKV / 32), I_O = (D / 64) * (D / 32), I_UP = (D / 64) * (FF / 32), I_DN = (FF / 64) * (D / 32), PER = I_IN + I_O + I_UP + I_DN;
    for (int it = gw; it < DEPTH * PER; it += NGW) {
        const int l = it / PER, j = l >> 1; int r = it % PER;
        if (r < I_IN) { const float* src = ((l & 1) ? F_DIFF_W_IN : F_MOBA_W_IN) + (size_t)j * D * NQKV; p0_transpose_item(src, D, NQKV, w_in_t(F, l), 0, scr, r, lane); continue; } r -= I_IN;
        if (r < I_O)  { const float* src = ((l & 1) ? F_DIFF_W_OUT : F_MOBA_W_OUT) + (size_t)j * D * D; p0_transpose_item(src, D, D, w_o_t(F, l), 0, scr, r, lane); continue; } r -= I_O;
        if (r < I_UP) { p0_transpose_item(F_W_UP + (size_t)l * D * FF, D, FF, w_up_t(F, l), 0, scr, r, lane); continue; } r -= I_UP;
        p0_transpose_item(F_W_DOWN + (size_t)l * FF * D, FF, D, w_dn_t(F, l), 0, scr, r, lane);
    }
    for (int e = F.vcu * (NWAVES * 64) + tid; e < SEQ * 8; e += F.G * NWAVES * 64) {
        const int pos = e >> 3, j = e & 7; const float ang = (float)pos * rope_inv(j);
        float s, c; sincos_f(ang, s, c);
        F_ROPE[pos * 16 + j] = c; F_ROPE[pos * 16 + 8 + j] = s;
    }
    __syncthreads();
    LAS float* sl = (LAS float*)(F.lds + RING_OFF);
    LAS float* red = (LAS float*)(F.lds + RING_OFF + 32768);
    for (int i = tid; i < BATCH * D; i += NWAVES * 64) { const float cv = F_C[i]; sl[i] = cv / (1.0f + expf(-cv)); }
    __syncthreads();
    for (int it = F.vcu; it < DEPTH * (MODW / 64); it += F.G) {
        const int l = it / (MODW / 64), ch = it % (MODW / 64);
        const float* w = F_ADA_W + (size_t)l * D * MODW + (size_t)(wave * 128) * MODW + ch * 64 + lane;
        float a[8];
#pragma unroll
        for (int b = 0; b < 8; ++b) a[b] = 0.f;
#pragma unroll 8
        for (int d = 0; d < 128; ++d) { const float wv = w[(size_t)d * MODW];
#pragma unroll
            for (int b = 0; b < 8; ++b) a[b] += sl[b * D + wave * 128 + d] * wv; }
#pragma unroll
        for (int b = 0; b < 8; ++b) red[(wave * 8 + b) * 64 + lane] = a[b];
        __syncthreads();
        { const int b = tid >> 6, cl = tid & 63; float s = F_ADA_B[l * MODW + ch * 64 + cl];
#pragma unroll
          for (int w8 = 0; w8 < 8; ++w8) s += red[(w8 * 8 + b) * 64 + cl];
          F_MOD[(size_t)(l * BATCH + b) * MODW + ch * 64 + cl] = s; }
        __syncthreads();
    }
}
__device__ __forceinline__ void p1_hm0(Frame& F) {
    PHASE_IDS;
    const int gw = F.vcu * NWAVES + wave, NGW = F.G * NWAVES;
    for (int m = gw; m < M; m += NGW) {
        const int b = m >> 11; const float* md = F_MOD + (size_t)b * MODW;
        const GAS f32x4* xr = (const GAS f32x4*)(F_X + (size_t)m * D) + lane;
        GAS unsigned long long* o8 = (GAS unsigned long long*)(F_HM + (size_t)m * D) + lane;
#pragma unroll
        for (int j = 0; j < 4; ++j) { const f32x4 v = xr[64 * j]; const int col = 4 * lane + 256 * j;
            const f32x4 sh = *(const f32x4*)(md + col), sc = *(const f32x4*)(md + 1024 + col);
            const f32x4 h = v * (sc + 1.0f) + sh;
            o8[64 * j] = (unsigned long long)pk2(h.x, h.y) | ((unsigned long long)pk2(h.z, h.w) << 32); }
    }
}
__device__ __forceinline__ void ln_rows_phase(Frame& F, float* x, const float* g, const float* bt, const float* shift, const float* scale, bf16* hm) {
    PHASE_IDS;
    const int gw = F.vcu * NWAVES + wave, NGW = F.G * NWAVES;
    for (int m = gw; m < M; m += NGW) {
        const int b = m >> 11;
        GAS f32x4* xr = (GAS f32x4*)(x + (size_t)m * D) + lane;
        f32x4 v[4]; float s = 0.f;
#pragma unroll
        for (int j = 0; j < 4; ++j) { v[j] = xr[64 * j]; s += (v[j].x + v[j].y) + (v[j].z + v[j].w); }
        const float mean = wave_sum(s) * (1.f / D); float s2 = 0.f;
#pragma unroll
        for (int j = 0; j < 4; ++j) { v[j] = v[j] - mean; s2 += (v[j].x * v[j].x + v[j].y * v[j].y) + (v[j].z * v[j].z + v[j].w * v[j].w); }
        const float rstd = 1.f / sqrtf(wave_sum(s2) * (1.f / D) + LN_EPS);
        GAS unsigned long long* o8 = (GAS unsigned long long*)(hm + (size_t)m * D) + lane;
#pragma unroll
        for (int j = 0; j < 4; ++j) { const int col = 4 * lane + 256 * j;
            const f32x4 xn = (v[j] * rstd) * *(const f32x4*)(g + col) + *(const f32x4*)(bt + col);
            xr[64 * j] = xn;
            if (hm) { const f32x4 h = xn * (*(const f32x4*)(scale + (size_t)b * MODW + col) + 1.0f) + *(const f32x4*)(shift + (size_t)b * MODW + col);
                o8[64 * j] = (unsigned long long)pk2(h.x, h.y) | ((unsigned long long)pk2(h.z, h.w) << 32); } }
    }
}
#if MK_CHECK
template <int DV>
__device__ __forceinline__ void naive_attend(const bf16* qrow, const bf16* Kb, const bf16* Vb, const int (&rs)[4], const int (&rc)[4], int nr, LAS float* sc, int lane, float& o0, float& o1) {
    unsigned qp[32];
#pragma unroll
    for (int i = 0; i < 8; ++i) { const v4u t = *(const v4u*)(qrow + 8 * i); qp[4 * i] = t.x; qp[4 * i + 1] = t.y; qp[4 * i + 2] = t.z; qp[4 * i + 3] = t.w; }
    float mx = -INFINITY; int off = 0;
#pragma unroll
    for (int r = 0; r < 4; ++r) if (r < nr) {
        for (int i = lane; i < rc[r]; i += 64) {
            const v4u* kp = (const v4u*)(Kb + (size_t)(rs[r] + i) * 1024);
            float dot = 0.f;
#pragma unroll
            for (int c8 = 0; c8 < 8; ++c8) { const v4u kk = kp[c8];
#pragma unroll
                for (int e = 0; e < 4; ++e) dot += __builtin_bit_cast(float, kk[e] << 16) * __builtin_bit_cast(float, qp[c8 * 4 + e] << 16) + __builtin_bit_cast(float, kk[e] & 0xffff0000u) * __builtin_bit_cast(float, qp[c8 * 4 + e] & 0xffff0000u); }
            sc[off + i] = dot; mx = fmaxf(mx, dot);
        }
        off += rc[r];
    }
    mx = wave_max(mx);
    LDS_WAIT();
    float sum = 0.f; o0 = 0.f; o1 = 0.f; off = 0;
#pragma unroll
    for (int r = 0; r < 4; ++r) if (r < nr) {
        const bf16* vp = Vb + (size_t)rs[r] * 1024 + lane;
#pragma unroll 4
        for (int i = 0; i < rc[r]; ++i) { const float p = __builtin_amdgcn_exp2f(sc[off + i] - mx); sum += p; o0 += p * bf2f(vp[(size_t)i * 1024]); if (DV == 128) o1 += p * bf2f(vp[(size_t)i * 1024 + 64]); }
        off += rc[r];
    }
    const float inv = 1.0f / sum; o0 *= inv; o1 *= inv;
    LDS_WAIT();
}
__device__ __forceinline__ void moba_naive_phase(Frame& F, bf16* Obuf) {
    PHASE_IDS;
    const int gw = F.vcu * NWAVES + wave, NGW = F.G * NWAVES;
    LAS float* sc = (LAS float*)(F.lds + RING_OFF) + wave * 2048;
    for (int it = gw; it < BATCH * 16 * SEQ; it += NGW) {
        const int bh = it & 127, s = it >> 7, b = bh >> 4, h = bh & 15, jq = s >> 8;
        const size_t rowb = (size_t)b * SEQ;
        const bf16* qrow = F_Q + (rowb + s) * 1024 + h * 64;
        const float qd = bf2f(qrow[lane]);
        float g[8];
#pragma unroll
        for (int n = 0; n < 8; ++n) { g[n] = -INFINITY;
            if (n < jq) { const float* kp = F_KPART + (size_t)((b * 8 + n) * 2) * 1024 + h * 64 + lane; g[n] = wave_sum(qd * (kp[0] + kp[1024])); } }
        unsigned picked = 0u; int selblk[3];
#pragma unroll
        for (int t = 0; t < 3; ++t) { float best = -INFINITY; int bi = -1;
#pragma unroll
            for (int n = 0; n < 8; ++n) { const bool ok = (n < jq) && !((picked >> n) & 1u) && (bi < 0 || g[n] > best); if (ok) { best = g[n]; bi = n; } }
            selblk[t] = bi; if (bi >= 0) picked |= 1u << bi; }
        int rs[4], rc[4];
        rs[0] = jq * 256; rc[0] = s - jq * 256 + 1;
#pragma unroll
        for (int t = 0; t < 3; ++t) { rs[t + 1] = selblk[t] * 256; rc[t + 1] = 256; }
        const int nr = 1 + (jq < 3 ? jq : 3);
        float o0, o1;
        naive_attend<64>(qrow, F_K + rowb * 1024 + h * 64, F_V + rowb * 1024 + h * 64, rs, rc, nr, sc, lane, o0, o1);
        Obuf[(rowb + s) * 1024 + h * 64 + lane] = (bf16)f2bf(o0);
    }
}
__device__ __forceinline__ void diff_naive_phase(Frame& F, int j, float lambda_init, bf16* Obuf) {
    PHASE_IDS;
    const int gw = F.vcu * NWAVES + wave, NGW = F.G * NWAVES;
    LAS float* sc = (LAS float*)(F.lds + RING_OFF) + wave * 2048;
    const float lam = expf(wave_sum(F_LAM_Q1[j * 64 + lane] * F_LAM_K1[j * 64 + lane])) - expf(wave_sum(F_LAM_Q2[j * 64 + lane] * F_LAM_K2[j * 64 + lane])) + lambda_init;
    const float g0 = F_SUBLN_G[j * 128 + lane] * (1.0f - lambda_init), g1 = F_SUBLN_G[j * 128 + 64 + lane] * (1.0f - lambda_init);
    for (int it = gw; it < BATCH * 8 * SEQ; it += NGW) {
        const int bh = it & 63, s = it >> 6, b = bh >> 3, h = bh & 7;
        const size_t rowb = (size_t)b * SEQ;
        int rs[4], rc[4]; rs[0] = 0; rc[0] = s + 1; rs[1] = rs[2] = rs[3] = 0; rc[1] = rc[2] = rc[3] = 0;
        float a0, a1, b0, b1;
        naive_attend<128>(F_Q + (rowb + s) * 1024 + h * 128, F_K + rowb * 1024 + h * 128, F_V + rowb * 1024 + h * 128, rs, rc, 1, sc, lane, a0, a1);
        naive_attend<128>(F_Q + (rowb + s) * 1024 + h * 128 + 64, F_K + rowb * 1024 + h * 128 + 64, F_V + rowb * 1024 + h * 128, rs, rc, 1, sc, lane, b0, b1);
        const float o0 = a0 - lam * b0, o1 = a1 - lam * b1;
        const float r = 1.0f / sqrtf(wave_sum(o0 * o0 + o1 * o1) * (1.0f / 128.0f) + SUBLN_EPS);
        Obuf[(rowb + s) * 1024 + h * 128 + lane] = (bf16)f2bf(o0 * r * g0);
        Obuf[(rowb + s) * 1024 + h * 128 + 64 + lane] = (bf16)f2bf(o1 * r * g1);
    }
}

#endif
__device__ __forceinline__ void moba_phase(Frame& F, bf16* Obuf) {
    for (int v = F.vcu; v < 256; v += F.G) {
        const int bh = v >> 1, p = v & 1, b = bh >> 4, h = bh & 15;
        const float* kp = F_KPART + (size_t)(b * 16) * 1024 + h * 64;
        for (int i = 0; i < 4; ++i) { const int qb = (i == 0) ? 7 - p : (i == 1) ? 5 - p : (i == 2) ? 2 + p : p;
            attn_body::attn_unit<8, true>(b, qb, (const attn_body::bf16*)F_Q + h * 64, (const attn_body::bf16*)F_K + h * 64, (const attn_body::bf16*)F_V + h * 64, (attn_body::bf16*)Obuf + h * 64, 1024, kp, F.ldsg + RING_OFF); }
    }
}
__device__ __forceinline__ void diff_phase(Frame& F, int j, float lambda_init, bf16* Tbuf, bf16* Obuf) {
    for (int v = F.vcu; v < 256; v += F.G) {
        const int bh = v >> 2, s = v & 3, b = bh >> 3, h = bh & 7;
        for (int i = 0; i < 2; ++i) { const int qb = (i == 0) ? 7 - s : s;
            for (int sub = 0; sub < 4; ++sub) { const int c = sub >> 1, vh = sub & 1;
                attn_body::attn_unit<8, false>(b, qb, (const attn_body::bf16*)F_Q + h * 128 + c * 64, (const attn_body::bf16*)F_K + h * 128 + c * 64, (const attn_body::bf16*)F_V + h * 128 + vh * 64,
                                               (attn_body::bf16*)Tbuf + h * 256 + c * 128 + vh * 64, 2048, nullptr, F.ldsg + RING_OFF); }
            VM_WAIT();
            int t2 = threadIdx.x; asm volatile("" : "+v"(t2)); const int lane = t2 & 63, wave = __builtin_amdgcn_readfirstlane(t2 >> 6);
            const float lam = expf(wave_sum(F_LAM_Q1[j * 64 + lane] * F_LAM_K1[j * 64 + lane])) - expf(wave_sum(F_LAM_Q2[j * 64 + lane] * F_LAM_K2[j * 64 + lane])) + lambda_init;
            const float g0 = F_SUBLN_G[j * 128 + 2 * lane] * (1.0f - lambda_init), g1 = F_SUBLN_G[j * 128 + 2 * lane + 1] * (1.0f - lambda_init);
            const size_t row0 = (size_t)b * SEQ + qb * 256 + wave * 32;
#pragma unroll 4
            for (int rr = 0; rr < 32; ++rr) {
                const gu32* tp = (const gu32*)(Tbuf + (row0 + rr) * 2048 + h * 256) + lane;
                const unsigned ua = __hip_atomic_load(tp, RLX_AGENT), ub = __hip_atomic_load(tp + 64, RLX_AGENT);
                const float o0 = __builtin_bit_cast(float, ua << 16) - lam * __builtin_bit_cast(float, ub << 16);
                const float o1 = __builtin_bit_cast(float, ua & 0xffff0000u) - lam * __builtin_bit_cast(float, ub & 0xffff0000u);
                const float r = 1.0f / sqrtf(wave_sum(o0 * o0 + o1 * o1) * (1.0f / 128.0f) + SUBLN_EPS);
                *((GAS unsigned*)(Obuf + (row0 + rr) * 1024 + h * 128) + lane) = pk2(o0 * r * g0, o1 * r * g1);
            }
        }
    }
}
#if MK_CHECK
__device__ __forceinline__ void cmp_phase(Frame& F, const bf16* A, const bf16* B, float rel, float abs_tol, int cw) {
    PHASE_IDS;
    unsigned cnt = 0;
    for (size_t i = (size_t)F.vcu * (NWAVES * 64) + tid; i < (size_t)M * D; i += (size_t)F.G * NWAVES * 64) {
        const float a = bf2f(A[i]), b = bf2f(B[i]); const float d = fabsf(a - b);
        if (!(d <= rel * fmaxf(fabsf(a), fabsf(b)) + abs_tol)) ++cnt;
    }
    if (cnt) __hip_atomic_fetch_add(F.ctl + cw, cnt, RLX_AGENT);
}
#endif

__global__ void __launch_bounds__(NWAVES * 64, 2) mk_fwd(Args args) {
    extern __shared__ __attribute__((aligned(16))) unsigned char lds[];
    Frame F;
    F.lds = (LAS unsigned char*)lds; F.ldsg = (char*)lds;
    F.MISC = (volatile LAS unsigned*)(F.lds + MISC_OFF);
    F.G = gridDim.x; { const int bx = blockIdx.x; F.vcu = (F.G % 8 == 0) ? (bx % 8) * (F.G / 8) + bx / 8 : bx; }
    unsigned char* ws = args.ws; F.ws = ws;
    F.ctl = (gu32*)(ws + WS_CTL);
    F.a = &args;
    for (int u = threadIdx.x; u < (LDS_BYTES - LDSCTL_OFF) / 4; u += NWAVES * 64) ((LAS unsigned*)(F.lds + LDSCTL_OFF))[u] = 0u;
    __syncthreads();
    const int lo = args.ph_lo, hi = args.ph_hi;
    XcdBarrier bar; bar.bar = (unsigned*)(F.ctl + CW_BAR); bar.x = 0; bar.st = nullptr;
    if (hi - lo > 1) bar = xcd_barrier_post((unsigned*)(F.ctl + CW_BAR), F.MISC + 8);
    for (int ph = lo; ph < hi; ++ph) {
        { unsigned long long w_ = (unsigned long long)args.ws; asm volatile("" : "+s"(w_)); F.ws = (unsigned char*)(GAS unsigned char*)w_; int z_ = 0; asm volatile("" : "+s"(z_)); F.z = z_; }
        if (ph == 0) p0_prologue(F);
        else if (ph == 1) p1_hm0(F);
        else {
            const int l = (ph - 2) / KPL; int kind = (ph - 2) % KPL; const int jm = l >> 1; const bool is_diff = (l & 1) != 0;
            const float* modl = F_MOD + (size_t)l * BATCH * MODW;
            const float lambda_init = (l == 1) ? 0.35550906759096934f : 0.5560582041556406f;
#if MK_CHECK
            const bool chk = is_diff ? ((MK_CHECK & 2) != 0) : ((MK_CHECK & 1) != 0);
            if (kind == 1) {
                if (chk) { if (is_diff) diff_naive_phase(F, jm, lambda_init, (bf16*)(F.ws + WS_DBG)); else moba_naive_phase(F, (bf16*)(F.ws + WS_DBG)); }
                kind = -1;
            } else if (kind == 3) {
                if (chk) cmp_phase(F, is_diff ? F_Q : F_O, (const bf16*)(F.ws + WS_DBG), 0.05f, is_diff ? 3e-2f : 1e-3f, CW_CHK);
                kind = -1;
            } else if (kind == 2) kind = 1; else if (kind > 3) kind -= 2;
#endif
            if (kind == 0) {
                pg8::Gemm g{F_HM, w_in_t(F, l), M, NQKV, D}; pg8::StaticOrder S; S.init(M, NQKV, F.G, (int)blockIdx.x);
                pg8::EpiQKV E{F_Q, (size_t)(WS_K - WS_Q) / 2, F_ROPE, is_diff ? nullptr : F_KPART, QSCALE};
                pg8::gemm_phase<pg8::EpiQKV, pg8::StaticOrder, PG8_ALIGN, PG8_SP2>(F.lds + RING_OFF, g, S, E);
            } else if (kind == 1) {
                if (is_diff) diff_phase(F, jm, lambda_init, F_O, F_Q);
                else moba_phase(F, F_O);
            } else if (kind == 2) {
                pg8::Gemm g{is_diff ? F_Q : F_O, w_o_t(F, l), M, D, D}; pg8::StaticOrder S; S.init(M, D, F.G, (int)blockIdx.x);
                pg8::EpiResid E{l == 0 ? F_X : (const float*)F_OUT, F_OUT, modl + 2048, DN_ALPHA};
                pg8::gemm_phase<pg8::EpiResid, pg8::StaticOrder, PG8_ALIGN, PG8_SP2>(F.lds + RING_OFF, g, S, E);
            } else if (kind == 3) {
                ln_rows_phase(F, F_OUT, F_LN_G + (size_t)(l * 2 + 0) * D, F_LN_B + (size_t)(l * 2 + 0) * D, modl + 3072, modl + 4096, F_HM);
            } else if (kind == 4) {
                pg8::Gemm g{F_HM, w_up_t(F, l), M, FF, D}; pg8::StaticOrder S; S.init(M, FF, F.G, (int)blockIdx.x);
                pg8::EpiSqRelu E{F_H, FF};
                pg8::gemm_phase<pg8::EpiSqRelu, pg8::StaticOrder, PG8_ALIGN, PG8_SP2>(F.lds + RING_OFF, g, S, E);
            } else if (kind == 5) {
                pg8::Gemm g{F_H, w_dn_t(F, l), M, D, FF}; pg8::StaticOrder S; S.init(M, D, F.G, (int)blockIdx.x);
                pg8::EpiResid E{F_OUT, F_OUT, modl + 5120, DN_ALPHA};
                pg8::gemm_phase<pg8::EpiResid, pg8::StaticOrder, PG8_ALIGN, PG8_SP2>(F.lds + RING_OFF, g, S, E);
            } else if (kind == 6) {
                const float* modn = modl + (size_t)BATCH * MODW;
                ln_rows_phase(F, F_OUT, F_LN_G + (size_t)(l * 2 + 1) * D, F_LN_B + (size_t)(l * 2 + 1) * D, modn + 0, modn + 1024, (l + 1 < DEPTH) ? F_HM : (bf16*)nullptr);
            }
        }
        if (ph + 1 < hi) xcd_barrier(bar);
    }
#if MK_CHECK
    if (hi == NPHASE && blockIdx.x == 0 && threadIdx.x == 0) { const unsigned cnt = __hip_atomic_load(F.ctl + CW_CHK, RLX_AGENT); if (cnt > MK_CHECK_THR) F_OUT[0] = 1.0e4f + (float)cnt; }
#endif
}

extern "C" void kernel_launch(void* const* d_in, const int* in_sizes, int n_in, void* d_out, int out_size, void* d_ws, size_t ws_size, hipStream_t stream) {
    static int grid = 0;
    if (grid == 0) {
        if (n_in != 17 || in_sizes[0] != M * D || out_size != M * D || ws_size < WS_END) { fprintf(stderr, "kernel_launch: built for 17 inputs, x and out of %d floats, >= %zu bytes of workspace; got n_in %d, in0 %d, out %d, ws %zu; nothing launched\n", M * D, (size_t)WS_END, n_in, n_in > 0 ? in_sizes[0] : -1, out_size, ws_size); grid = -1; return; }
        int dev = 0, cus = 0, per_cu = 0;
        if (hipGetDevice(&dev) != hipSuccess || hipDeviceGetAttribute(&cus, hipDeviceAttributeMultiprocessorCount, dev) != hipSuccess) { fprintf(stderr, "kernel_launch: hipGetDevice / hipDeviceGetAttribute failed; nothing launched\n"); grid = -1; return; }
        if (hipFuncSetAttribute((const void*)mk_fwd, hipFuncAttributeMaxDynamicSharedMemorySize, LDS_BYTES) != hipSuccess) { fprintf(stderr, "kernel_launch: hipFuncSetAttribute failed\n"); grid = -1; return; }
        if (hipOccupancyMaxActiveBlocksPerMultiprocessor(&per_cu, (const void*)mk_fwd, NWAVES * 64, LDS_BYTES) != hipSuccess || per_cu < 1)
            fprintf(stderr, "kernel_launch: note: the occupancy query reports %d workgroups per CU\n", per_cu);
        (void)hipGetLastError();
        grid = cus;
        if (grid != 256) fprintf(stderr, "kernel_launch: launching %d workgroups (built for 256 CUs)\n", grid);
    }
    if (grid < 0) return;
    if (hipMemsetAsync((char*)d_ws + WS_CTL, 0, CTL_ZERO_BYTES, stream) != hipSuccess) { fprintf(stderr, "kernel_launch: hipMemsetAsync of the control words failed; nothing launched\n"); return; }
    Args a{};
    for (int i = 0; i < 17; ++i) a.in[i] = (const float*)d_in[i];
    a.out = (float*)d_out; a.ws = (unsigned char*)d_ws;
#if MK_PER_PHASE
    for (int p = 0; p < NPHASE; ++p) { a.ph_lo = p; a.ph_hi = p + 1; hipLaunchKernelGGL(mk_fwd, dim3(grid), dim3(NWAVES * 64), LDS_BYTES, stream, a); }
#else
    a.ph_lo = 0; a.ph_hi = NPHASE;
    hipLaunchKernelGGL(mk_fwd, dim3(grid), dim3(NWAVES * 64), LDS_BYTES, stream, a);
#endif
    const hipError_t le = hipPeekAtLastError();
    if (le != hipSuccess) fprintf(stderr, "kernel_launch: launch failed: %s (grid %d x %d threads, %d B LDS)\n", hipGetErrorName(le), grid, NWAVES * 64, LDS_BYTES);
}
```
